# Optimizing an MI355X kernel written in HIP

```python
import jax
import jax.numpy as jnp
from jax import lax
import numpy as np

D_MODEL = 2048
BATCH = 2
SEQ = 4096
DEPTH = 4
DEC_BATCH = 8
DEC_SEQ = 4
PAST_LEN = 16384
PAGE_SIZE = 128

D_POOL = D_MODEL // 2
POOL_WINDOWS = (2, 4, 8, 16)
N_POOL_GROUPS = len(POOL_WINDOWS)
D_POOL_GROUP = D_POOL // N_POOL_GROUPS
POOL_HIST = max(POOL_WINDOWS) - 1
D_CONV = D_MODEL // 2
CONV_WIDTH = 3
CONV_HIST = CONV_WIDTH - 1
HEAD_DIM = 128
N_HEADS = D_MODEL // HEAD_DIM
D_ATTN = N_HEADS * HEAD_DIM
DILATED_GROUPS = ((128, 1), (512, 4), (2048, 16))
MAX_WINDOW = max(w for w, _ in DILATED_GROUPS)
Q_BLOCK = 128
ATTN_SCALE = HEAD_DIM ** -0.5
N_AB_LAYERS = (DEPTH + 1) // 2
N_C_LAYERS = DEPTH // 2
D_IN_AB = 2 * D_POOL + 4 * D_CONV
D_IN_C = 4 * D_ATTN
RMS_EPS = 1e-6
NEG_INF = -1e30

kernel_name = 'pool_conv_dilated_hybrid_step'


def _rmsnorm(x, w):
    xf = x.astype(jnp.float32)
    y = xf * lax.rsqrt(jnp.mean(xf * xf, axis=-1, keepdims=True) + RMS_EPS)
    return (y * w).astype(x.dtype)


def _multiscale_pool(u_hist, u, pos0):
    T = u.shape[1]
    ua = jnp.concatenate([u_hist, u], axis=1)
    c = jnp.cumsum(ua.astype(jnp.float32), axis=1)
    c = jnp.concatenate([jnp.zeros_like(c[:, :1]), c], axis=1)
    end = c[:, POOL_HIST + 1:]
    pos = (pos0 + jnp.arange(T)).astype(jnp.float32)
    means = []
    for g, k in enumerate(POOL_WINDOWS):
        sl = slice(g * D_POOL_GROUP, (g + 1) * D_POOL_GROUP)
        start = c[:, POOL_HIST + 1 - k: POOL_HIST + 1 - k + T, sl]
        cnt = jnp.minimum(float(k), pos + 1.0)[None, :, None]
        means.append((end[..., sl] - start) / cnt)
    mixed = jnp.concatenate(means, axis=-1) - u.astype(jnp.float32)
    return mixed.astype(u.dtype), ua[:, -POOL_HIST:]


def _short_conv(z_hist, z, w):
    T = z.shape[1]
    za = jnp.concatenate([z_hist, z], axis=1)
    y = za[:, 0:T] * w[0]
    for i in range(1, CONV_WIDTH):
        y = y + za[:, i:i + T] * w[i]
    return y, za[:, -CONV_HIST:]


def _ab_layer(x_n, pool_hist, conv_hist, pos0, w_in, p_lin, p_scale, c_w, w_out):
    B, T, _ = x_n.shape
    proj = x_n @ w_in
    cuts = [D_POOL, 2 * D_POOL, 2 * D_POOL + D_CONV, 2 * D_POOL + 2 * D_CONV, 2 * D_POOL + 3 * D_CONV]
    u, g_a, b_gate, c_gate, h, g_b = jnp.split(proj, cuts, axis=-1)
    pooled, new_pool = _multiscale_pool(pool_hist, u, pos0)
    pooled = pooled.reshape(B, T, N_POOL_GROUPS, D_POOL_GROUP)
    a_mix = jnp.einsum('btgc,gcd->btgd', pooled, p_lin).reshape(B, T, D_POOL) * p_scale
    a_out = a_mix * jax.nn.silu(g_a)
    conv, new_conv = _short_conv(conv_hist, c_gate * h, c_w)
    b_out = b_gate * conv * jax.nn.silu(g_b)
    y = jnp.concatenate([a_out, b_out], axis=-1) @ w_out
    return y, new_pool, new_conv


def _band_attn(q, k, v, n_back):
    lead = q.shape[:-2]
    L, hd = q.shape[-2:]
    nb = -(-L // Q_BLOCK)
    Lp = nb * Q_BLOCK
    pad = [(0, 0)] * len(lead) + [(0, Lp - L), (0, 0)]

    def blocks(a):
        return jnp.pad(a, pad).reshape(*lead, nb, Q_BLOCK, hd)

    def with_prev(a):
        prev = jnp.concatenate([jnp.zeros_like(a[..., :1, :, :]), a[..., :-1, :, :]], axis=-3)
        return jnp.concatenate([prev, a], axis=-2)

    qb = blocks(q)
    kk = with_prev(blocks(k))
    vv = with_prev(blocks(v))
    s = jnp.einsum('...qd,...kd->...qk', qb, kk).astype(jnp.float32) * ATTN_SCALE
    qi = jnp.arange(Q_BLOCK)[:, None] + Q_BLOCK
    ki = jnp.arange(2 * Q_BLOCK)[None, :]
    dist = qi - ki
    band = (dist >= 0) & (dist <= n_back)
    has_prev = (jnp.arange(nb) > 0)[:, None, None] | (ki >= Q_BLOCK)[None]
    mask = band[None] & has_prev
    s = jnp.where(mask, s, NEG_INF)
    m = jnp.max(s, axis=-1, keepdims=True)
    p = jnp.exp(s - m)
    den = jnp.sum(p, axis=-1, keepdims=True)
    o = jnp.einsum('...qk,...kd->...qd', p, vv.astype(jnp.float32)) / den
    lse = (m + jnp.log(den))[..., 0]
    o = o.reshape(*lead, Lp, hd)[..., :L, :]
    lse = lse.reshape(*lead, Lp)[..., :L]
    return o, lse


def _dilated_prompt(q, k, v, window, dil):
    B, T, H, hd = q.shape
    L = T // dil

    def split(a):
        return a.reshape(B, L, dil, H, hd).transpose(0, 2, 3, 1, 4)

    o, lse = _band_attn(split(q), split(k), split(v), window // dil)
    o = o.transpose(0, 3, 1, 2, 4).reshape(B, T, H, hd)
    lse = lse.transpose(0, 3, 1, 2).reshape(B, T, H)
    return o, lse


def _dilated_sample(q, k_all, v_all, n_buf, window, dil):
    S = q.shape[1]
    n_keys = window // dil + 1
    idx = n_buf + jnp.arange(S)[:, None] - dil * jnp.arange(n_keys)[None, :]
    valid = idx >= 0
    idx = jnp.maximum(idx, 0)
    kg = k_all[:, idx]
    vg = v_all[:, idx]
    s = jnp.einsum('bshd,bsnhd->bshn', q, kg).astype(jnp.float32) * ATTN_SCALE
    s = jnp.where(valid[None, :, None, :], s, NEG_INF)
    m = jnp.max(s, axis=-1, keepdims=True)
    p = jnp.exp(s - m)
    den = jnp.sum(p, axis=-1, keepdims=True)
    o = jnp.einsum('bshn,bsnhd->bshd', p, vg.astype(jnp.float32)) / den
    lse = (m + jnp.log(den))[..., 0]
    return o, lse


def _merge_by_denominator(results):
    outs = jnp.stack([o for o, _ in results], axis=0)
    wts = jax.nn.softmax(jnp.stack([l for _, l in results], axis=0), axis=0)
    return jnp.einsum('gbth,gbthd->bthd', wts, outs)


def _c_project(x_n, w_in):
    B, T, _ = x_n.shape
    q, k, v, g = jnp.split(x_n @ w_in, 4, axis=-1)
    heads = lambda a: a.reshape(B, T, N_HEADS, HEAD_DIM)
    return heads(q), heads(k), heads(v), g


def _c_out(o, g, w_out):
    B, T = g.shape[:2]
    return (o.reshape(B, T, D_ATTN).astype(g.dtype) * jax.nn.silu(g)) @ w_out


def _c_layer_prompt(x_n, w_in, w_out):
    q, k, v, g = _c_project(x_n, w_in)
    o = _merge_by_denominator([_dilated_prompt(q, k, v, w, d) for w, d in DILATED_GROUPS])
    n_keep = min(MAX_WINDOW, x_n.shape[1])
    return _c_out(o, g, w_out), k[:, -n_keep:], v[:, -n_keep:]


def _c_layer_sample(x_n, k_buf, v_buf, w_in, w_out):
    q, k, v, g = _c_project(x_n, w_in)
    n_buf = k_buf.shape[1]
    k_all = jnp.concatenate([k_buf, k], axis=1)
    v_all = jnp.concatenate([v_buf, v], axis=1)
    o = _merge_by_denominator([_dilated_sample(q, k_all, v_all, n_buf, w, d) for w, d in DILATED_GROUPS])
    n_keep = min(MAX_WINDOW, n_buf + x_n.shape[1])
    return _c_out(o, g, w_out), k_all[:, -n_keep:], v_all[:, -n_keep:]


def setup_inputs(seed: int = 0) -> dict:
    key = jax.random.key(seed)
    ks = jax.random.split(key, 16)
    f32 = jnp.float32

    def nrm(k, shape, scale):
        return jax.random.normal(k, shape, f32) * scale

    n_buf = min(MAX_WINDOW, PAST_LEN)
    return {
        'x_prompt': nrm(ks[0], (BATCH, SEQ, D_MODEL), 1.0),
        'x_sample': nrm(ks[1], (DEC_BATCH, DEC_SEQ, D_MODEL), 1.0),
        'state_pool': nrm(ks[2], (N_AB_LAYERS, DEC_BATCH, POOL_HIST, D_POOL), 1.0),
        'state_conv': nrm(ks[3], (N_AB_LAYERS, DEC_BATCH, CONV_HIST, D_CONV), 1.0),
        'cache_k': nrm(ks[4], (N_C_LAYERS, DEC_BATCH, n_buf, N_HEADS, HEAD_DIM), 1.0),
        'cache_v': nrm(ks[5], (N_C_LAYERS, DEC_BATCH, n_buf, N_HEADS, HEAD_DIM), 1.0),
        'norm_w': 1.0 + nrm(ks[6], (DEPTH, D_MODEL), 0.05),
        'final_norm_w': 1.0 + nrm(ks[7], (D_MODEL,), 0.05),
        'w_in_ab': nrm(ks[8], (N_AB_LAYERS, D_MODEL, D_IN_AB), D_MODEL ** -0.5),
        'pool_lin': nrm(ks[9], (N_AB_LAYERS, N_POOL_GROUPS, D_POOL_GROUP, D_POOL_GROUP), D_POOL_GROUP ** -0.5),
        'pool_scale': 1.0 + nrm(ks[10], (N_AB_LAYERS, D_POOL), 0.05),
        'conv_w': nrm(ks[11], (N_AB_LAYERS, CONV_WIDTH, D_CONV), CONV_WIDTH ** -0.5),
        'w_out_ab': nrm(ks[12], (N_AB_LAYERS, D_POOL + D_CONV, D_MODEL), (D_POOL + D_CONV) ** -0.5),
        'w_in_c': nrm(ks[13], (N_C_LAYERS, D_MODEL, D_IN_C), D_MODEL ** -0.5),
        'w_out_c': nrm(ks[14], (N_C_LAYERS, D_ATTN, D_MODEL), D_ATTN ** -0.5),
    }


def reference(x_prompt, x_sample, state_pool, state_conv, cache_k, cache_v, norm_w, final_norm_w,
              w_in_ab, pool_lin, pool_scale, conv_w, w_out_ab, w_in_c, w_out_c):
    bp = x_prompt.shape[0]
    zero_pool = jnp.zeros((bp, POOL_HIST, D_POOL), x_prompt.dtype)
    zero_conv = jnp.zeros((bp, CONV_HIST, D_CONV), x_prompt.dtype)
    hp, hs = x_prompt, x_sample
    pool_p, pool_s, conv_p, conv_s = [], [], [], []
    k_p, k_s, v_p, v_s = [], [], [], []
    for l in range(DEPTH):
        i = l // 2
        xp_n = _rmsnorm(hp, norm_w[l])
        xs_n = _rmsnorm(hs, norm_w[l])
        if l % 2 == 0:
            yp, pp, cp = _ab_layer(xp_n, zero_pool, zero_conv, 0, w_in_ab[i], pool_lin[i],
                                   pool_scale[i], conv_w[i], w_out_ab[i])
            ys, ps, cs = _ab_layer(xs_n, state_pool[i], state_conv[i], PAST_LEN, w_in_ab[i], pool_lin[i],
                                   pool_scale[i], conv_w[i], w_out_ab[i])
            pool_p.append(pp)
            pool_s.append(ps)
            conv_p.append(cp)
            conv_s.append(cs)
        else:
            yp, kp, vp = _c_layer_prompt(xp_n, w_in_c[i], w_out_c[i])
            ys, ksn, vsn = _c_layer_sample(xs_n, cache_k[i], cache_v[i], w_in_c[i], w_out_c[i])
            k_p.append(kp)
            v_p.append(vp)
            k_s.append(ksn)
            v_s.append(vsn)
        hp = hp + yp
        hs = hs + ys
    y_prompt = _rmsnorm(hp, final_norm_w)
    y_sample = _rmsnorm(hs, final_norm_w)
    return (y_prompt, y_sample, jnp.stack(pool_p), jnp.stack(pool_s), jnp.stack(conv_p), jnp.stack(conv_s),
            jnp.stack(k_p), jnp.stack(k_s), jnp.stack(v_p), jnp.stack(v_s))
```

```cpp
#include <hip/hip_runtime.h>
#include <hip/hip_cooperative_groups.h>
#include <cstdio>
#include <cstdint>
namespace cg = cooperative_groups;
namespace pg8 {
#define PG8_LAS __attribute__((address_space(3)))
typedef unsigned short bf16_t;
typedef short bf16x8 __attribute__((ext_vector_type(8)));
typedef float f32x4 __attribute__((ext_vector_type(4)));
typedef unsigned u32x4 __attribute__((ext_vector_type(4)));
constexpr int BM = 256, BK = 64, HALF = 128, HTB = HALF * BK * 2  , STAGE_BYTES = 8 * HTB, NXCD = 8, WGM = 8;

__host__ __device__ __forceinline__ int lds_byte(int r, int c) { const int st = (r >> 4) * 2 + (c >> 5), rr = r & 15, cc = c & 31, ob = rr * 64 + cc * 2; return st * 1024 + (ob ^ (((ob >> 9) & 1) << 5)); }
__host__ __device__ __forceinline__ void stage_rc(int b, int& R, int& C) { const int st = b / 1024, sb = b % 1024, swz = sb ^ (((sb >> 9) & 1) << 5); R = (st >> 1) * 16 + swz / 64; C = (st & 1) * 32 + (swz % 64) / 2; }
__host__ __device__ __forceinline__ int perm32(int rho) { const int n = rho >> 4, i = rho & 15; return 8 * (i >> 2) + 4 * n + (i & 3); }

struct Unit { int pm, pn; };
struct Gemm { const bf16_t* A; const bf16_t* Bt; int M, N, K; };

struct StaticOrder {
    int nM, nN, nwg, G, c;
    __host__ __device__ void init(int M, int N, int G_, int c_) { nM = M / BM; nN = N / BM; nwg = nM * nN; G = G_; c = c_; }
    __host__ __device__ bool next(int i, Unit& u) const {
        const long L = (long)i * G + c; if (L >= nwg) return false;
        int wgid = (int)L; { const int q = nwg / NXCD, r = nwg % NXCD, xcd = wgid % NXCD, off = wgid / NXCD; wgid = (xcd < r ? xcd * (q + 1) : r * (q + 1) + (xcd - r) * q) + off; }
        const int nig = WGM * nN, gid = wgid / nig, fm = gid * WGM, gsz = (nM - fm) < WGM ? (nM - fm) : WGM;
        u.pm = fm + ((wgid % nig) % gsz); u.pn = (wgid % nig) / gsz; return true;
    }
    __device__ __forceinline__ void a_ready(const Unit&) const {}
    __device__ __forceinline__ void done(const Unit&) const {}
};
__device__ __forceinline__ unsigned cvt_pk_bf16(float lo, float hi) { unsigned r; asm volatile("v_cvt_pk_bf16_f32 %0, %1, %2" : "=v"(r) : "v"(lo), "v"(hi)); return r; }
template <class Epi, class Sched, bool STAMP = false>
__device__ __forceinline__ void gemm_phase(PG8_LAS unsigned char* lds, const Gemm g, const Sched& S, const Epi& E, unsigned long long* stamps) {
    int tid_l = threadIdx.x; asm volatile("" : "+v"(tid_l)); const int tid = tid_l, wid = __builtin_amdgcn_readfirstlane(tid >> 6), lane = tid & 63, wr = wid >> 2, wc = wid & 3, fr = lane & 15, fq = lane >> 4;
    const int K = g.K, nt = K / BK;
    int ts_lo = 0, ts_hi = 0, nts = 0; const unsigned long long rt_entry = STAMP ? (unsigned long long)wall_clock64() : 0ull;
#define PG8_STAMP() do { if (STAMP && wid == 0 && nts < 64) { const unsigned long long _c = (unsigned long long)clock64(); \
        ts_lo = (lane == nts) ? (int)(unsigned)_c : ts_lo; ts_hi = (lane == nts) ? (int)(unsigned)(_c >> 32) : ts_hi; ++nts; } } while (0)
    PG8_STAMP();
    unsigned voffA[2], voffB[2];
#pragma unroll
    for (int i = 0; i < 2; ++i) { int R, C; stage_rc(tid * 16 + i * 8192, R, C); const int Rb = Epi::PERM ? ((R & ~31) + perm32(R & 31)) : R;
        voffA[i] = (unsigned)(R * K + C) * 2u; voffB[i] = (unsigned)(Rb * K + C) * 2u; }
    const size_t kstep = (size_t)(BK * 2);
    const size_t hstep = (size_t)HALF * K * 2;
    const size_t tstep = 2 * hstep;
    const unsigned ldsw = (unsigned)wid * 1024u;
    const int aoff = lds_byte(wr * 64 + fr, fq * 8), boff = lds_byte(wc * 32 + fr, fq * 8);
#define PG8_SA(b, h) (((b) * 2 + (h)) * HTB)
#define PG8_SB(b, h) ((4 + (b) * 2 + (h)) * HTB)
#define PG8_STAGE(bufoff, gbase, voff) do { _Pragma("unroll") for (int _i = 0; _i < 2; ++_i) \
        __builtin_amdgcn_global_load_lds((const unsigned*)((const char*)(gbase) + (voff)[_i]), (PG8_LAS unsigned*)(lds + (bufoff) + ldsw + _i * 8192), 16, 0, 0); } while (0)
#define PG8_LDA(dst, b, h) do { _Pragma("unroll") for (int m = 0; m < 4; ++m) _Pragma("unroll") for (int k = 0; k < 2; ++k) dst[m][k] = *(const PG8_LAS bf16x8*)(lds + PG8_SA(b, h) + aoff + m * 2048 + k * 1024); } while (0)
#define PG8_LDB(dst, b, h) do { _Pragma("unroll") for (int n = 0; n < 2; ++n) _Pragma("unroll") for (int k = 0; k < 2; ++k) dst[n][k] = *(const PG8_LAS bf16x8*)(lds + PG8_SB(b, h) + boff + n * 2048 + k * 1024); } while (0)
#define PG8_MMA(ai, bj, At, Bt) do { __builtin_amdgcn_s_setprio(1); _Pragma("unroll") for (int m = 0; m < 4; ++m) _Pragma("unroll") for (int n = 0; n < 2; ++n) _Pragma("unroll") for (int k = 0; k < 2; ++k) \
        acc[ai][bj][m][n] = __builtin_amdgcn_mfma_f32_16x16x32_bf16(Bt[n][k], At[m][k], acc[ai][bj][m][n], 0, 0, 0); __builtin_amdgcn_s_setprio(0); } while (0)
#define PG8_WAIT_V(n) asm volatile("s_waitcnt vmcnt(" #n ")" ::: "memory")
#define PG8_WAIT_L(n) asm volatile("s_waitcnt lgkmcnt(" #n ")" ::: "memory")
#define PG8_BAR __builtin_amdgcn_s_barrier()
#define PG8_SCHED __builtin_amdgcn_sched_barrier(0)
    Unit cur, nxt; int ui = 0;
    if (!S.next(0, cur)) return;
    f32x4 acc[2][2][4][2];
#pragma unroll
    for (int a = 0; a < 2; ++a)
#pragma unroll
        for (int b = 0; b < 2; ++b)
#pragma unroll
            for (int m = 0; m < 4; ++m)
#pragma unroll
                for (int n = 0; n < 2; ++n) acc[a][b][m][n] = (f32x4){0.f, 0.f, 0.f, 0.f};
    bf16x8 At[4][2], B0[2][2], B1[2][2];
    const char* cA = (const char*)g.A + (size_t)cur.pm * tstep; const char* cB = (const char*)g.Bt + (size_t)cur.pn * tstep;
    S.a_ready(cur);
    PG8_STAGE(PG8_SB(0, 0), cB, voffB); PG8_STAGE(PG8_SA(0, 0), cA, voffA); PG8_STAGE(PG8_SB(0, 1), cB + hstep, voffB); PG8_STAGE(PG8_SA(0, 1), cA + hstep, voffA);
    if (wr == 1) PG8_BAR;
    PG8_WAIT_V(4); PG8_BAR;
    PG8_STAGE(PG8_SB(1, 0), cB + kstep, voffB); PG8_STAGE(PG8_SA(1, 0), cA + kstep, voffA); PG8_STAGE(PG8_SB(1, 1), cB + hstep + kstep, voffB);
    PG8_WAIT_V(6); PG8_BAR;
    PG8_STAMP();
    for (;;) {
        const bool has_next = S.next(ui + 1, nxt);
        const char* nA = has_next ? (const char*)g.A + (size_t)nxt.pm * tstep : cA; const char* nB = has_next ? (const char*)g.Bt + (size_t)nxt.pn * tstep : cB;
        for (int t = 0; t < nt; t += 2) {
            const bool last = (t == nt - 2);
            const char* a1 = cA + (size_t)(t + 1) * kstep;
            const char* a2 = last ? nA : cA + (size_t)(t + 2) * kstep; const char* b2 = last ? nB : cB + (size_t)(t + 2) * kstep;
            const char* a3 = a2 + kstep; const char* b3 = b2 + kstep;
            if (last && has_next) S.a_ready(nxt);
            PG8_LDB(B0, 0, 0); PG8_SCHED; PG8_LDA(At, 0, 0); PG8_STAGE(PG8_SA(1, 1), a1 + hstep, voffA);
            PG8_WAIT_L(8); PG8_BAR; PG8_WAIT_L(0); PG8_MMA(0, 0, At, B0); PG8_BAR; PG8_SCHED;
            PG8_LDB(B1, 0, 1); PG8_STAGE(PG8_SB(0, 0), b2, voffB);
            PG8_BAR; PG8_WAIT_L(0); PG8_MMA(0, 1, At, B1); PG8_BAR;
            PG8_LDA(At, 0, 1); PG8_STAGE(PG8_SA(0, 0), a2, voffA);
            PG8_BAR; PG8_WAIT_L(0); PG8_MMA(1, 0, At, B0); PG8_BAR; PG8_SCHED;
            PG8_STAGE(PG8_SB(0, 1), b2 + hstep, voffB);
            PG8_WAIT_V(6); PG8_BAR; PG8_MMA(1, 1, At, B1); PG8_BAR;
            PG8_LDB(B0, 1, 0); PG8_SCHED; PG8_LDA(At, 1, 0); PG8_STAGE(PG8_SA(0, 1), a2 + hstep, voffA);
            PG8_WAIT_L(8); PG8_BAR; PG8_WAIT_L(0); PG8_MMA(0, 0, At, B0); PG8_BAR; PG8_SCHED;
            PG8_LDB(B1, 1, 1); PG8_STAGE(PG8_SB(1, 0), b3, voffB);
            PG8_BAR; PG8_WAIT_L(0); PG8_MMA(0, 1, At, B1); PG8_BAR;
            PG8_LDA(At, 1, 1); PG8_STAGE(PG8_SA(1, 0), a3, voffA);
            PG8_BAR; PG8_WAIT_L(0); PG8_MMA(1, 0, At, B0); PG8_BAR; PG8_SCHED;
            PG8_STAGE(PG8_SB(1, 1), b3 + hstep, voffB);
            PG8_WAIT_V(6); PG8_BAR; PG8_MMA(1, 1, At, B1); PG8_BAR;
        }
        PG8_STAMP();
        if constexpr (!Epi::AFTER_DRAIN) { E(acc, cur, wr, wc, fr, fq); S.done(cur); }
        PG8_STAMP();
        if (!has_next) break;
#pragma unroll
        for (int a = 0; a < 2; ++a)
#pragma unroll
            for (int b = 0; b < 2; ++b)
#pragma unroll
                for (int m = 0; m < 4; ++m)
#pragma unroll
                    for (int n = 0; n < 2; ++n) acc[a][b][m][n] = (f32x4){0.f, 0.f, 0.f, 0.f};
        cur = nxt; cA = nA; cB = nB; ++ui;
    }
    PG8_WAIT_V(0);
    if (wr == 0) PG8_BAR;
    PG8_BAR;
    if constexpr (Epi::AFTER_DRAIN) { E.fused(acc, cur, wr, wc, fr, fq, lds, wid, lane); S.done(cur); }
    PG8_STAMP();
    if (STAMP && wid == 0) { stamps[lane] = lane < nts ? (((unsigned long long)(unsigned)ts_hi << 32) | (unsigned)ts_lo) : 0ull;
        if (lane == 62) stamps[62] = rt_entry; if (lane == 63) stamps[63] = (unsigned long long)wall_clock64(); }
#undef PG8_STAMP
#undef PG8_SA
#undef PG8_SB
#undef PG8_STAGE
#undef PG8_LDA
#undef PG8_LDB
#undef PG8_MMA
#undef PG8_WAIT_V
#undef PG8_WAIT_L
#undef PG8_BAR
#undef PG8_SCHED
}
}

#define LAS __attribute__((address_space(3)))
typedef unsigned short bf16_t;
typedef short bf16x8 __attribute__((ext_vector_type(8)));
typedef short s16x4 __attribute__((ext_vector_type(4)));
typedef short v4i16_t __attribute__((ext_vector_type(4)));
typedef float f32x4 __attribute__((ext_vector_type(4)));
typedef float f32x2 __attribute__((ext_vector_type(2)));
typedef float f32x16 __attribute__((ext_vector_type(16)));
typedef unsigned u32x4 __attribute__((ext_vector_type(4)));
typedef unsigned u32x2 __attribute__((ext_vector_type(2)));
using pg8::cvt_pk_bf16;

constexpr int DM = 2048, MP = 8192, MS = 32, MT = MP + MS;
constexpr int NAB = 6144, NC = 8192;
constexpr size_t al256(size_t x) { return (x + 255) & ~(size_t)255; }
constexpr size_t WS_XB = 0;
constexpr size_t WS_H = al256(WS_XB + (size_t)MT * DM * 2);
constexpr size_t WS_RSS = al256(WS_H + (size_t)MT * DM * 4);
constexpr size_t WS_PROJ = al256(WS_RSS + (size_t)5 * MT * 4);
constexpr size_t WS_ZCAT = al256(WS_PROJ + (size_t)MT * NC * 2);
constexpr size_t WS_OG = al256(WS_ZCAT + (size_t)MT * DM * 2);
constexpr size_t WS_LSE = al256(WS_OG + (size_t)3 * MP * DM * 2);
constexpr size_t WS_WINAB = al256(WS_LSE + (size_t)3 * MP * 16 * 4);
constexpr size_t WS_WOUTAB = al256(WS_WINAB + (size_t)2 * NAB * DM * 2);
constexpr size_t WS_WINC = al256(WS_WOUTAB + (size_t)2 * DM * DM * 2);
constexpr size_t WS_WOUTC = al256(WS_WINC + (size_t)2 * NC * DM * 2);
constexpr size_t WS_PLIN = al256(WS_WOUTC + (size_t)2 * DM * DM * 2);
constexpr size_t WS_END = al256(WS_PLIN + (size_t)2 * 4 * 256 * 256 * 2);
constexpr size_t O_YP = 0, O_YS = O_YP + (size_t)MP * DM, O_PP = O_YS + (size_t)MS * DM, O_PS = O_PP + 2 * 2 * 15 * 1024, O_CP = O_PS + 2 * 8 * 15 * 1024,
                 O_CS = O_CP + 2 * 2 * 2 * 1024, O_KP = O_CS + 2 * 8 * 2 * 1024, O_KS = O_KP + (size_t)2 * 2 * 2048 * 2048, O_VP = O_KS + (size_t)2 * 8 * 2048 * 2048,
                 O_VS = O_VP + (size_t)2 * 2 * 2048 * 2048, O_END = O_VS + (size_t)2 * 8 * 2048 * 2048;
constexpr int LDS_BYTES = 131072;
constexpr float QSCALE = 0.08838834764831845f * 1.4426950408889634f;

struct Params { const float* in[15]; float* out; unsigned char* ws; };
__device__ __forceinline__ int ltid() { int t = threadIdx.x; asm volatile("" : "+v"(t)); return t; }
__device__ __forceinline__ int lbid() { int t = blockIdx.x; asm volatile("" : "+s"(t)); return t; }
typedef const __attribute__((address_space(4))) Params* KP;
__device__ __forceinline__ KP getp() { KP pp = (KP)__builtin_amdgcn_kernarg_segment_ptr(); asm volatile("" : "+s"(pp)); return pp; }
enum { I_XP = 0, I_XS, I_SPOOL, I_SCONV, I_CK, I_CV, I_NW, I_FNW, I_WINAB, I_PLIN, I_PSCALE, I_CONVW, I_WOUTAB, I_WINC, I_WOUTC };

__device__ __forceinline__ float bf2f(bf16_t b) { return __uint_as_float(((unsigned)b) << 16); }
__device__ __forceinline__ float bflo(unsigned w) { return __uint_as_float(w << 16); }
__device__ __forceinline__ float bfhi(unsigned w) { return __uint_as_float(w & 0xffff0000u); }
__device__ __forceinline__ float silu_f(float x) { return x / (1.f + __expf(-x)); }
__device__ __forceinline__ float wave_sum(float v) {
#pragma unroll
    for (int o = 32; o >= 1; o >>= 1) v += __shfl_xor(v, o);
    return v; }
__device__ __forceinline__ float wave_max(float v) {
#pragma unroll
    for (int o = 32; o >= 1; o >>= 1) v = fmaxf(v, __shfl_xor(v, o));
    return v; }

struct QInAB {
    static constexpr bool NEED_SS = false;
    const float* rss; bf16_t* proj; float* rss_next;
    __device__ __forceinline__ float rowscale(int row) const { return rsqrtf(rss[row] * (1.f / 2048.f) + 1e-6f); }
    __device__ __forceinline__ void quad(int row, int col, f32x4 v, float rs, float& ss) const {
        v *= rs;
        if ((col >= 1024 && col < 2048) || col >= 5120) { v[0] = silu_f(v[0]); v[1] = silu_f(v[1]); v[2] = silu_f(v[2]); v[3] = silu_f(v[3]); }
        u32x2 w; w.x = cvt_pk_bf16(v[0], v[1]); w.y = cvt_pk_bf16(v[2], v[3]);
        *(u32x2*)(proj + (size_t)row * NAB + col) = w;
    }
};
struct QInC {
    static constexpr bool NEED_SS = false;
    const float* rss; bf16_t* qkvg; float* kp; float* ks; float* vp; float* vs; float* rss_next;
    __device__ __forceinline__ float rowscale(int row) const { return rsqrtf(rss[row] * (1.f / 2048.f) + 1e-6f); }
    __device__ __forceinline__ void quad(int row, int col, f32x4 v, float rs, float& ss) const {
        v *= rs;
        const int seg = col >> 11, cc = col & 2047;
        if (seg == 1 || seg == 2) {
            float* dst;
            if (row < MP) { const int b = row >> 12, t = row & 4095; dst = (t >= 2048) ? ((seg == 1 ? kp : vp) + ((size_t)(b * 2048 + (t - 2048)) * 2048 + cc)) : nullptr; }
            else { const int r = row - MP, b = r >> 2, s = r & 3; dst = (seg == 1 ? ks : vs) + ((size_t)(b * 2048 + 2044 + s) * 2048 + cc); }
            if (dst) *(f32x4*)dst = v;
        }
        if (seg == 0) v *= QSCALE;
        if (seg == 3) { v[0] = silu_f(v[0]); v[1] = silu_f(v[1]); v[2] = silu_f(v[2]); v[3] = silu_f(v[3]); }
        u32x2 w; w.x = cvt_pk_bf16(v[0], v[1]); w.y = cvt_pk_bf16(v[2], v[3]);
        *(u32x2*)(qkvg + (size_t)row * NC + col) = w;
    }
};
struct QOut {
    static constexpr bool NEED_SS = true;
    const float* hold_p; const float* hold_s; float* hbuf; bf16_t* xb; float* rss_next;
    __device__ __forceinline__ float rowscale(int) const { return 1.f; }
    __device__ __forceinline__ void quad(int row, int col, f32x4 v, float rs, float& ss) const {
        const float* src = row < MP ? hold_p + (size_t)row * DM : hold_s + (size_t)(row - MP) * DM;
        const f32x4 o = *(const f32x4*)(src + col) + v;
        *(f32x4*)(hbuf + (size_t)row * DM + col) = o;
        u32x2 w; w.x = cvt_pk_bf16(o[0], o[1]); w.y = cvt_pk_bf16(o[2], o[3]);
        *(u32x2*)(xb + (size_t)row * DM + col) = w;
        ss += (o[0] * o[0] + o[1] * o[1]) + (o[2] * o[2] + o[3] * o[3]);
    }
};
template <class Q> struct EpiMain {
    static constexpr bool PERM = false, AFTER_DRAIN = false;
    Q q;
    __device__ __forceinline__ void operator()(const f32x4 (&acc)[2][2][4][2], const pg8::Unit& u, int wr, int wc, int fr, int fq) const {
        const int row0 = u.pm * 256 + wr * 64 + fr, col0 = u.pn * 256 + wc * 32 + 4 * fq;
#pragma unroll
        for (int ai = 0; ai < 2; ++ai)
#pragma unroll
            for (int m = 0; m < 4; ++m) {
                const int row = row0 + ai * 128 + m * 16; const float rs = q.rowscale(row); float ss = 0.f;
#pragma unroll
                for (int bj = 0; bj < 2; ++bj)
#pragma unroll
                    for (int n = 0; n < 2; ++n) q.quad(row, col0 + bj * 128 + n * 16, acc[ai][bj][m][n], rs, ss);
                if (Q::NEED_SS) { ss += __shfl_xor(ss, 16); ss += __shfl_xor(ss, 32); if (fq == 0) atomicAdd(q.rss_next + row, ss); }
                asm volatile("" ::: "memory");
            }
    }
};
template <class Q> __device__ __forceinline__ void skinny_gemm(const bf16_t* A, const bf16_t* Bt, int N, const Q& q) {
    const int tid = ltid(), wid = tid >> 6, lane = tid & 63, fr = lane & 15, fq = lane >> 4;
    const int ntask = N / 16;
    for (int task = wid * gridDim.x + blockIdx.x; task < ntask; task += 8 * gridDim.x) {
        const int n0 = task * 16;
        const bf16_t* a0 = A + (size_t)(MP + fr) * DM + fq * 8; const bf16_t* a1 = a0 + (size_t)16 * DM;
        const bf16_t* bp = Bt + (size_t)(n0 + fr) * DM + fq * 8;
        f32x4 c0 = {0.f, 0.f, 0.f, 0.f}, c1 = {0.f, 0.f, 0.f, 0.f};
#pragma unroll 8
        for (int kk = 0; kk < DM; kk += 32) {
            const bf16x8 b = *(const bf16x8*)(bp + kk), x0 = *(const bf16x8*)(a0 + kk), x1 = *(const bf16x8*)(a1 + kk);
            c0 = __builtin_amdgcn_mfma_f32_16x16x32_bf16(b, x0, c0, 0, 0, 0);
            c1 = __builtin_amdgcn_mfma_f32_16x16x32_bf16(b, x1, c1, 0, 0, 0);
        }
#pragma unroll
        for (int hh = 0; hh < 2; ++hh) {
            const int row = MP + hh * 16 + fr; const float rs = q.rowscale(row); float ss = 0.f;
            q.quad(row, n0 + 4 * fq, hh ? c1 : c0, rs, ss);
            if (Q::NEED_SS) { ss += __shfl_xor(ss, 16); ss += __shfl_xor(ss, 32); if (fq == 0) atomicAdd(q.rss_next + row, ss); }
        }
    }
}

__device__ __forceinline__ void conv_tile(const float* W, int ldw, int K, bf16_t* Bt, const float* scale, int k0, int n0, LAS char* lds) {
    constexpr int PITCH = 258;
    LAS bf16_t* T = (LAS bf16_t*)lds;
    const int tid = ltid();
#pragma unroll
    for (int p = 0; p < 8; ++p) {
        const int k = p * 8 + (tid >> 6), c4 = (tid & 63) * 4;
        f32x4 v = __builtin_nontemporal_load((const f32x4*)(W + (size_t)(k0 + k) * ldw + n0 + c4));
        const float s = scale ? scale[k0 + k] : 1.f;
        v *= s;
        LAS unsigned* d = (LAS unsigned*)(T + k * PITCH + c4);
        d[0] = cvt_pk_bf16(v[0], v[1]); d[1] = cvt_pk_bf16(v[2], v[3]);
    }
    __syncthreads();
#pragma unroll
    for (int j = 0; j < 4; ++j) {
        const int ch = tid + j * 512, n = ch >> 3, kc = ch & 7;
        unsigned w[4];
#pragma unroll
        for (int e = 0; e < 4; ++e) { const unsigned lo = T[(kc * 8 + 2 * e) * PITCH + n], hi = T[(kc * 8 + 2 * e + 1) * PITCH + n]; w[e] = lo | (hi << 16); }
        u32x4 o = {w[0], w[1], w[2], w[3]};
        *(u32x4*)(Bt + (size_t)(n0 + n) * K + k0 + kc * 8) = o;
    }
    __syncthreads();
}
__device__ __forceinline__ void phase0(LAS char* lds) {
    KP p = getp();
    const int tid = ltid(), wid = tid >> 6, lane = tid & 63;
    unsigned char* ws = p->ws;
    for (int tile = blockIdx.x; tile < 4640; tile += gridDim.x) {
        const float* W; int ldw, K; bf16_t* Bt; const float* sc; int r;
        if (tile < 4608) {
            const int i = tile / 2304; r = tile % 2304; K = 2048;
            if (r < 768) { W = p->in[I_WINAB] + (size_t)i * DM * NAB; ldw = NAB; Bt = (bf16_t*)(ws + WS_WINAB) + (size_t)i * NAB * DM; sc = p->in[I_NW] + (2 * i) * DM; }
            else if (r < 1024) { r -= 768; W = p->in[I_WOUTAB] + (size_t)i * DM * DM; ldw = DM; Bt = (bf16_t*)(ws + WS_WOUTAB) + (size_t)i * DM * DM; sc = nullptr; }
            else if (r < 2048) { r -= 1024; W = p->in[I_WINC] + (size_t)i * DM * NC; ldw = NC; Bt = (bf16_t*)(ws + WS_WINC) + (size_t)i * NC * DM; sc = p->in[I_NW] + (2 * i + 1) * DM; }
            else { r -= 2048; W = p->in[I_WOUTC] + (size_t)i * DM * DM; ldw = DM; Bt = (bf16_t*)(ws + WS_WOUTC) + (size_t)i * DM * DM; sc = nullptr; }
        } else { const int t2 = tile - 4608, mtx = t2 >> 2; r = t2 & 3; K = 256; ldw = 256; W = p->in[I_PLIN] + (size_t)mtx * 65536; Bt = (bf16_t*)(ws + WS_PLIN) + (size_t)mtx * 65536; sc = nullptr; }
        const int nN = ldw / 256, kt = r / nN, nt = r % nN;
        conv_tile(W, ldw, K, Bt, sc, kt * 64, nt * 256, lds);
    }
    float* rss = (float*)(ws + WS_RSS); bf16_t* xb = (bf16_t*)(ws + WS_XB);
    const int gw = blockIdx.x * 8 + wid, nw = gridDim.x * 8;
    for (int row = gw; row < MT; row += nw) {
        const float* src = row < MP ? p->in[I_XP] + (size_t)row * DM : p->in[I_XS] + (size_t)(row - MP) * DM;
        float ss = 0.f;
#pragma unroll
        for (int i = 0; i < 8; ++i) {
            const f32x4 v = *(const f32x4*)(src + (i * 64 + lane) * 4);
            ss += (v[0] * v[0] + v[1] * v[1]) + (v[2] * v[2] + v[3] * v[3]);
            u32x2 w; w.x = cvt_pk_bf16(v[0], v[1]); w.y = cvt_pk_bf16(v[2], v[3]);
            *(u32x2*)(xb + (size_t)row * DM + (i * 64 + lane) * 4) = w;
        }
        ss = wave_sum(ss);
        if (lane == 0) rss[row] = ss;
    }
    const int gtid = blockIdx.x * 512 + tid, nth = gridDim.x * 512;
    for (int i = gtid; i < 4 * MT; i += nth) rss[MT + i] = 0.f;
    constexpr int CH4 = 2044 * 2048 / 4;
    for (int c = 0; c < 32; ++c) {
        const int kv = c >> 4, ib = c & 15;
        const f32x4* src = (const f32x4*)(p->in[kv ? I_CV : I_CK] + ((size_t)ib * 2048 + 4) * 2048);
        f32x4* dst = (f32x4*)(p->out + (kv ? O_VS : O_KS) + (size_t)ib * 2048 * 2048);
        int i = gtid;
        for (; i + 3 * nth < CH4; i += 4 * nth) {
            const f32x4 a = __builtin_nontemporal_load(src + i), b = __builtin_nontemporal_load(src + i + nth), cc = __builtin_nontemporal_load(src + i + 2 * nth), d = __builtin_nontemporal_load(src + i + 3 * nth);
            __builtin_nontemporal_store(a, dst + i); __builtin_nontemporal_store(b, dst + i + nth); __builtin_nontemporal_store(cc, dst + i + 2 * nth); __builtin_nontemporal_store(d, dst + i + 3 * nth);
        }
        for (; i < CH4; i += nth) __builtin_nontemporal_store(__builtin_nontemporal_load(src + i), dst + i);
    }
}

__device__ __forceinline__ void mixer_phase(int i, LAS char* lds) {
    KP p = getp();
    const int tid = ltid(), wid = tid >> 6, lane = tid & 63, fr = lane & 15, fq = lane >> 4;
    unsigned char* ws = p->ws;
    const bf16_t* proj = (const bf16_t*)(ws + WS_PROJ); bf16_t* zcat = (bf16_t*)(ws + WS_ZCAT);
    const bf16_t* plinT = (const bf16_t*)(ws + WS_PLIN) + (size_t)i * 4 * 65536;
    const float* pscale = p->in[I_PSCALE] + i * 1024; const float* convw = p->in[I_CONVW] + i * 3 * 1024;
    constexpr int APITCH = 528;
    for (int task = blockIdx.x; task < 256; task += gridDim.x) {
        const int rt = task >> 2, g = task & 3, b = rt >> 5, t0 = (rt & 31) * 128, kwin = 2 << g;
        const size_t rbase = (size_t)b * 4096;
        {
            const int cp = tid & 127, rc = tid >> 7, c = g * 256 + 2 * cp, tstart = t0 + rc * 32;
            const bf16_t* ub = proj + c;
            float s0 = 0.f, s1 = 0.f;
            for (int j = 1; j < kwin; ++j) { const int t = tstart - j; if (t >= 0) { const unsigned w = *(const unsigned*)(ub + (rbase + t) * NAB); s0 += bflo(w); s1 += bfhi(w); } }
            float* pp = p->out + O_PP + ((size_t)(i * 2 + b) * 15) * 1024 + c;
            for (int ii = 0; ii < 32; ++ii) {
                const int t = tstart + ii;
                const unsigned w = *(const unsigned*)(ub + (rbase + t) * NAB); const float c0 = bflo(w), c1 = bfhi(w);
                s0 += c0; s1 += c1;
                const float inv = 1.f / fminf((float)kwin, (float)(t + 1));
                *(LAS unsigned*)(lds + (rc * 32 + ii) * APITCH + cp * 4) = cvt_pk_bf16(s0 * inv - c0, s1 * inv - c1);
                if (t >= 4081) { f32x2 o = {c0, c1}; *(f32x2*)(pp + (size_t)(t - 4081) * 1024) = o; }
                const int told = t - kwin + 1;
                if (told >= 0) { const unsigned w2 = *(const unsigned*)(ub + (rbase + told) * NAB); s0 -= bflo(w2); s1 -= bfhi(w2); }
            }
        }
        {
            const int cp = tid & 127, rc = tid >> 7, c = g * 256 + 2 * cp, tstart = t0 + rc * 32;
            const float w00 = convw[c], w01 = convw[c + 1], w10 = convw[1024 + c], w11 = convw[1024 + c + 1], w20 = convw[2048 + c], w21 = convw[2048 + c + 1];
            float zm2a = 0.f, zm2b = 0.f, zm1a = 0.f, zm1b = 0.f;
            if (tstart >= 2) { const size_t ro = (rbase + tstart - 2) * NAB; const unsigned cg_ = *(const unsigned*)(proj + ro + 3072 + c), hh = *(const unsigned*)(proj + ro + 4096 + c); zm2a = bflo(cg_) * bflo(hh); zm2b = bfhi(cg_) * bfhi(hh); }
            if (tstart >= 1) { const size_t ro = (rbase + tstart - 1) * NAB; const unsigned cg_ = *(const unsigned*)(proj + ro + 3072 + c), hh = *(const unsigned*)(proj + ro + 4096 + c); zm1a = bflo(cg_) * bflo(hh); zm1b = bfhi(cg_) * bfhi(hh); }
            float* cpo = p->out + O_CP + ((size_t)(i * 2 + b) * 2) * 1024 + c;
            for (int ii = 0; ii < 32; ++ii) {
                const int t = tstart + ii; const size_t ro = (rbase + t) * NAB;
                const unsigned cg_ = *(const unsigned*)(proj + ro + 3072 + c), hh = *(const unsigned*)(proj + ro + 4096 + c), bg = *(const unsigned*)(proj + ro + 2048 + c), sg = *(const unsigned*)(proj + ro + 5120 + c);
                const float za = bflo(cg_) * bflo(hh), zb = bfhi(cg_) * bfhi(hh);
                const float ya = zm2a * w00 + zm1a * w10 + za * w20, yb = zm2b * w01 + zm1b * w11 + zb * w21;
                *(unsigned*)(zcat + (rbase + t) * DM + 1024 + c) = cvt_pk_bf16(bflo(bg) * ya * bflo(sg), bfhi(bg) * yb * bfhi(sg));
                if (t >= 4094) { f32x2 o = {za, zb}; *(f32x2*)(cpo + (size_t)(t - 4094) * 1024) = o; }
                zm2a = zm1a; zm2b = zm1b; zm1a = za; zm1b = zb;
            }
        }
        __syncthreads();
        {
            const int wr = wid >> 2, wc = wid & 3;
            f32x4 acc[4][4];
#pragma unroll
            for (int m = 0; m < 4; ++m)
#pragma unroll
                for (int n = 0; n < 4; ++n) acc[m][n] = (f32x4){0.f, 0.f, 0.f, 0.f};
            const bf16_t* Bg = plinT + (size_t)g * 65536 + (size_t)(wc * 64 + fr) * 256 + fq * 8;
            LAS const char* Al = lds + (wr * 64 + fr) * APITCH + fq * 16;
#pragma unroll 2
            for (int ks = 0; ks < 8; ++ks) {
                bf16x8 a[4], bb[4];
#pragma unroll
                for (int m = 0; m < 4; ++m) a[m] = *(LAS const bf16x8*)(Al + m * 16 * APITCH + ks * 64);
#pragma unroll
                for (int n = 0; n < 4; ++n) bb[n] = *(const bf16x8*)(Bg + (size_t)n * 16 * 256 + ks * 32);
#pragma unroll
                for (int m = 0; m < 4; ++m)
#pragma unroll
                    for (int n = 0; n < 4; ++n) acc[m][n] = __builtin_amdgcn_mfma_f32_16x16x32_bf16(bb[n], a[m], acc[m][n], 0, 0, 0);
            }
#pragma unroll
            for (int m = 0; m < 4; ++m) {
                const size_t row = rbase + t0 + wr * 64 + m * 16 + fr;
#pragma unroll
                for (int n = 0; n < 4; ++n) {
                    const int ch = g * 256 + wc * 64 + n * 16 + fq * 4;
                    const f32x4 sc = *(const f32x4*)(pscale + ch);
                    const u32x2 sg = *(const u32x2*)(proj + row * NAB + 1024 + ch);
                    const f32x4 v = acc[m][n] * sc;
                    u32x2 w; w.x = cvt_pk_bf16(v[0] * bflo(sg.x), v[1] * bfhi(sg.x)); w.y = cvt_pk_bf16(v[2] * bflo(sg.y), v[3] * bfhi(sg.y));
                    *(u32x2*)(zcat + row * DM + ch) = w;
                }
            }
        }
        __syncthreads();
    }
    for (int st = blockIdx.x; st < 32; st += gridDim.x) {
        const int b = st >> 2, g = st & 3, kwin = 2 << g;
        LAS float* PS = (LAS float*)lds;
        if (tid < 256) {
            const int c = g * 256 + tid;
            float ua[19];
            const float* sp = p->in[I_SPOOL] + ((size_t)(i * 8 + b) * 15) * 1024 + c;
#pragma unroll
            for (int j = 0; j < 15; ++j) ua[j] = sp[(size_t)j * 1024];
#pragma unroll
            for (int s = 0; s < 4; ++s) ua[15 + s] = bf2f(proj[(size_t)(MP + b * 4 + s) * NAB + c]);
            const float inv = 1.f / (float)kwin;
#pragma unroll
            for (int s = 0; s < 4; ++s) {
                float a = 0.f;
#pragma unroll
                for (int j = 0; j < 16; ++j) a += (j < kwin) ? ua[15 + s - j] : 0.f;
                PS[s * 256 + tid] = a * inv - ua[15 + s];
            }
            float* po = p->out + O_PS + ((size_t)(i * 8 + b) * 15) * 1024 + c;
#pragma unroll
            for (int j = 0; j < 15; ++j) po[(size_t)j * 1024] = ua[4 + j];
            const float* scv = p->in[I_SCONV] + ((size_t)(i * 8 + b) * 2) * 1024 + c;
            float za[6]; za[0] = scv[0]; za[1] = scv[1024];
#pragma unroll
            for (int s = 0; s < 4; ++s) { const size_t ro = (size_t)(MP + b * 4 + s) * NAB; za[2 + s] = bf2f(proj[ro + 3072 + c]) * bf2f(proj[ro + 4096 + c]); }
            const float w0 = convw[c], w1 = convw[1024 + c], w2 = convw[2048 + c];
#pragma unroll
            for (int s = 0; s < 4; ++s) {
                const size_t ro = (size_t)(MP + b * 4 + s) * NAB;
                const float y = za[s] * w0 + za[s + 1] * w1 + za[s + 2] * w2;
                const float o = bf2f(proj[ro + 2048 + c]) * y * bf2f(proj[ro + 5120 + c]);
                zcat[(size_t)(MP + b * 4 + s) * DM + 1024 + c] = (bf16_t)(cvt_pk_bf16(o, 0.f) & 0xffffu);
            }
            float* co = p->out + O_CS + ((size_t)(i * 8 + b) * 2) * 1024 + c;
            co[0] = za[4]; co[1024] = za[5];
        }
        __syncthreads();
        {
            const int d = tid & 255, sp2 = tid >> 8;
            const float* P = p->in[I_PLIN] + ((size_t)(i * 4 + g) * 256) * 256 + d;
            float a0 = 0.f, a1 = 0.f;
#pragma unroll 8
            for (int c = 0; c < 256; ++c) { const float w = P[(size_t)c * 256]; a0 += PS[(2 * sp2) * 256 + c] * w; a1 += PS[(2 * sp2 + 1) * 256 + c] * w; }
            const int ch = g * 256 + d; const float sc = pscale[ch];
            const size_t r0 = (size_t)(MP + b * 4 + 2 * sp2), r1 = r0 + 1;
            zcat[r0 * DM + ch] = (bf16_t)(cvt_pk_bf16(a0 * sc * bf2f(proj[r0 * NAB + 1024 + ch]), 0.f) & 0xffffu);
            zcat[r1 * DM + ch] = (bf16_t)(cvt_pk_bf16(a1 * sc * bf2f(proj[r1 * NAB + 1024 + ch]), 0.f) & 0xffffu);
        }
        __syncthreads();
    }
}

__device__ __forceinline__ int crow(int r, int hi) { return (r & 3) + 8 * (r >> 2) + 4 * hi; }
__device__ __forceinline__ s16x4 vtr(LAS const char* ptr) { return __builtin_bit_cast(s16x4, __builtin_amdgcn_ds_read_tr16_b64_v4i16((LAS v4i16_t*)ptr)); }
__device__ __forceinline__ void attn_wave_task(const bf16_t* qkvg, int b, int h, int dil, int r, int m0, bf16_t* og, float* lse, LAS char* vl, int lane) {
    constexpr int VP = 320;
    const int r32 = lane & 31, hi = lane >> 5;
    const bf16_t* qb = qkvg + h * 128, * kb = qkvg + 2048 + h * 128, * vb = qkvg + 4096 + h * 128;
    const size_t rowb = (size_t)b * 4096 + r;
    const size_t qrow = rowb + (size_t)(m0 + r32) * dil;
    bf16x8 qf[8];
#pragma unroll
    for (int d0 = 0; d0 < 8; ++d0) qf[d0] = *(const bf16x8*)(qb + qrow * NC + d0 * 16 + hi * 8);
    f32x16 o[4];
#pragma unroll
    for (int dt = 0; dt < 4; ++dt)
#pragma unroll
        for (int e = 0; e < 16; ++e) o[dt][e] = 0.f;
    float m_run = -1e30f, l_run = 0.f;
    const int i16 = lane & 15, tq = i16 >> 2, tp = i16 & 3, dblk = (lane >> 4) & 1;
    LAS const char* trb = vl + (4 * hi + tq) * VP + dblk * 32 + 8 * tp;
    const int kt0 = m0 >= 128 ? 0 : (128 - m0) / 32;
    for (int kt = kt0; kt < 5; ++kt) {
        const int mk0 = m0 - 128 + 32 * kt;
        const size_t krow = rowb + (size_t)(mk0 + r32) * dil;
        bf16x8 kf[8];
#pragma unroll
        for (int d0 = 0; d0 < 8; ++d0) kf[d0] = *(const bf16x8*)(kb + krow * NC + d0 * 16 + hi * 8);
        bf16x8 vs[8];
#pragma unroll
        for (int ii = 0; ii < 8; ++ii) { const size_t vrow = rowb + (size_t)(mk0 + ii * 4 + (lane >> 4)) * dil; vs[ii] = *(const bf16x8*)(vb + vrow * NC + i16 * 8); }
        f32x16 pt;
#pragma unroll
        for (int e = 0; e < 16; ++e) pt[e] = 0.f;
#pragma unroll
        for (int d0 = 0; d0 < 8; ++d0) pt = __builtin_amdgcn_mfma_f32_32x32x16_bf16(kf[d0], qf[d0], pt, 0, 0, 0);
        const float NEG = -__builtin_inff();
        if (kt == 0) {
#pragma unroll
            for (int e = 0; e < 16; ++e) if (crow(e, hi) < r32) pt[e] = NEG;
        }
        if (kt == 4) {
#pragma unroll
            for (int e = 0; e < 16; ++e) if (crow(e, hi) > r32) pt[e] = NEG;
        }
        float tmax = pt[0];
#pragma unroll
        for (int e = 1; e < 16; ++e) tmax = fmaxf(tmax, pt[e]);
        { auto rr = __builtin_amdgcn_permlane32_swap(__float_as_uint(tmax), __float_as_uint(tmax), false, false); tmax = fmaxf(__uint_as_float(rr[0]), __uint_as_float(rr[1])); }
        const float mn = fmaxf(m_run, tmax), alpha = __builtin_amdgcn_exp2f(m_run - mn); m_run = mn;
        float ps = 0.f;
#pragma unroll
        for (int e = 0; e < 16; ++e) { pt[e] = __builtin_amdgcn_exp2f(pt[e] - mn); ps += pt[e]; }
        { auto rr = __builtin_amdgcn_permlane32_swap(__float_as_uint(ps), __float_as_uint(ps), false, false); ps = __uint_as_float(rr[0]) + __uint_as_float(rr[1]); }
        l_run = l_run * alpha + ps;
#pragma unroll
        for (int dt = 0; dt < 4; ++dt)
#pragma unroll
            for (int e = 0; e < 16; ++e) o[dt][e] *= alpha;
#pragma unroll
        for (int ii = 0; ii < 8; ++ii) *(LAS bf16x8*)(vl + (ii * 4 + (lane >> 4)) * VP + i16 * 16) = vs[ii];
        bf16x8 pb[2];
#pragma unroll
        for (int s = 0; s < 2; ++s) {
            u32x4 w; w.x = cvt_pk_bf16(pt[8 * s + 0], pt[8 * s + 1]); w.y = cvt_pk_bf16(pt[8 * s + 2], pt[8 * s + 3]); w.z = cvt_pk_bf16(pt[8 * s + 4], pt[8 * s + 5]); w.w = cvt_pk_bf16(pt[8 * s + 6], pt[8 * s + 7]);
            pb[s] = __builtin_bit_cast(bf16x8, w);
        }
        __builtin_amdgcn_fence(__ATOMIC_RELEASE, "wavefront");
        __builtin_amdgcn_wave_barrier();
#pragma unroll
        for (int dt = 0; dt < 4; ++dt)
#pragma unroll
            for (int s = 0; s < 2; ++s) {
                const s16x4 lo = vtr(trb + s * 16 * VP + dt * 64), hh = vtr(trb + s * 16 * VP + 8 * VP + dt * 64);
                const bf16x8 va = __builtin_shufflevector(lo, hh, 0, 1, 2, 3, 4, 5, 6, 7);
                o[dt] = __builtin_amdgcn_mfma_f32_32x32x16_bf16(va, pb[s], o[dt], 0, 0, 0);
            }
        __builtin_amdgcn_wave_barrier();
    }
    const float inv = 1.f / l_run;
    bf16_t* orow = og + qrow * DM + h * 128 + 4 * hi;
#pragma unroll
    for (int dt = 0; dt < 4; ++dt)
#pragma unroll
        for (int g4 = 0; g4 < 4; ++g4) {
            u32x2 w; w.x = cvt_pk_bf16(o[dt][4 * g4] * inv, o[dt][4 * g4 + 1] * inv); w.y = cvt_pk_bf16(o[dt][4 * g4 + 2] * inv, o[dt][4 * g4 + 3] * inv);
            *(u32x2*)(orow + dt * 32 + 8 * g4) = w;
        }
    if (hi == 0) lse[qrow * 16 + h] = m_run + __builtin_amdgcn_logf(l_run);
}
__device__ __forceinline__ void attn_sample_task(KP p, int i, int b, int s, int h, LAS char* wl, int lane) {
    const bf16_t* qkvg = (const bf16_t*)(p->ws + WS_PROJ); bf16_t* zcat = (bf16_t*)(p->ws + WS_ZCAT);
    const int row = MP + b * 4 + s;
    LAS float* sc = (LAS float*)wl;
    const int kq = lane >> 4, dc = lane & 15;
    float q8[8];
    { const bf16x8 qv = *(const bf16x8*)(qkvg + (size_t)row * NC + h * 128 + dc * 8);
#pragma unroll
      for (int e = 0; e < 8; ++e) q8[e] = bf2f((bf16_t)qv[e]); }
    const float* ck = p->in[I_CK] + ((size_t)(i * 8 + b) * 2048) * 2048 + h * 128;
    const float* cv = p->in[I_CV] + ((size_t)(i * 8 + b) * 2048) * 2048 + h * 128;
    const float* kn = p->out + O_KS + ((size_t)(i * 8 + b) * 2048 + 2044) * 2048 + h * 128;
    const float* vn = p->out + O_VS + ((size_t)(i * 8 + b) * 2048 + 2044) * 2048 + h * 128;
    for (int g = 0; g < 3; ++g) {
        const int dil = 1 << (2 * g);
#pragma unroll 4
        for (int j0 = 0; j0 < 132; j0 += 4) {
            const int j = j0 + kq, jc = j > 128 ? 128 : j, idx = 2048 + s - dil * jc;
            const float* kr = idx >= 2048 ? kn + (size_t)(idx - 2048) * 2048 : ck + (size_t)idx * 2048;
            const f32x4 a = *(const f32x4*)(kr + dc * 8), bq = *(const f32x4*)(kr + dc * 8 + 4);
            float d = (a[0] * q8[0] + a[1] * q8[1]) + (a[2] * q8[2] + a[3] * q8[3]) + (bq[0] * q8[4] + bq[1] * q8[5]) + (bq[2] * q8[6] + bq[3] * q8[7]);
            d += __shfl_xor(d, 1); d += __shfl_xor(d, 2); d += __shfl_xor(d, 4); d += __shfl_xor(d, 8);
            if (dc == 0 && j <= 128) sc[g * 132 + j] = d;
        }
    }
    __builtin_amdgcn_fence(__ATOMIC_RELEASE, "wavefront"); __builtin_amdgcn_wave_barrier();
    float mx = -1e30f;
    for (int f = lane; f < 387; f += 64) { const int g = f / 129, j = f - g * 129; mx = fmaxf(mx, sc[g * 132 + j]); }
    mx = wave_max(mx);
    float sum = 0.f;
    for (int f = lane; f < 387; f += 64) { const int g = f / 129, j = f - g * 129; const float e = __builtin_amdgcn_exp2f(sc[g * 132 + j] - mx); sc[g * 132 + j] = e; sum += e; }
    sum = wave_sum(sum);
    __builtin_amdgcn_fence(__ATOMIC_RELEASE, "wavefront"); __builtin_amdgcn_wave_barrier();
    float o0 = 0.f, o1 = 0.f;
    for (int g = 0; g < 3; ++g) {
        const int dil = 1 << (2 * g);
#pragma unroll 8
        for (int j = 0; j < 129; ++j) {
            const int idx = 2048 + s - dil * j;
            const float* vr = idx >= 2048 ? vn + (size_t)(idx - 2048) * 2048 : cv + (size_t)idx * 2048;
            const f32x2 v = *(const f32x2*)(vr + lane * 2);
            const float pj = sc[g * 132 + j];
            o0 += pj * v[0]; o1 += pj * v[1];
        }
    }
    const float inv = 1.f / sum;
    const unsigned sg = *(const unsigned*)(qkvg + (size_t)row * NC + 6144 + h * 128 + lane * 2);
    *(unsigned*)(zcat + (size_t)row * DM + h * 128 + lane * 2) = cvt_pk_bf16(o0 * inv * bflo(sg), o1 * inv * bfhi(sg));
    __builtin_amdgcn_wave_barrier();
}
__device__ __forceinline__ void attn_phase(int i, LAS char* lds) {
    KP p = getp();
    const int tid = ltid(), wid = tid >> 6, lane = tid & 63;
    const bf16_t* qkvg = (const bf16_t*)(p->ws + WS_PROJ); bf16_t* zcat = (bf16_t*)(p->ws + WS_ZCAT);
    bf16_t* og = (bf16_t*)(p->ws + WS_OG); float* lse = (float*)(p->ws + WS_LSE);
    LAS char* wl = lds + wid * 10240;
    for (int id = blockIdx.x; id < 256; id += gridDim.x) {
        const int x = id & 7, jj = id >> 3, bh = x + 8 * (jj >> 3), win = jj & 7, b = bh >> 4, h = bh & 15, T0 = win * 512;
        for (int tk = wid; tk < 48; tk += 8) {
            const int g = tk >> 4, sub = tk & 15;
            int dil, r, m0;
            if (g == 0) { dil = 1; r = 0; m0 = T0 + 32 * sub; }
            else if (g == 1) { dil = 4; r = sub & 3; m0 = (T0 >> 2) + 32 * (sub >> 2); }
            else { dil = 16; r = sub; m0 = T0 >> 4; }
            attn_wave_task(qkvg, b, h, dil, r, m0, og + (size_t)g * MP * DM, lse + (size_t)g * MP * 16, wl, lane);
        }
        __syncthreads();
#pragma unroll 2
        for (int j = 0; j < 16; ++j) {
            const size_t row = (size_t)b * 4096 + T0 + (tid >> 4) + 32 * j; const int ch = h * 128 + (tid & 15) * 8;
            const float l0 = lse[row * 16 + h], l1 = lse[(size_t)MP * 16 + row * 16 + h], l2 = lse[(size_t)2 * MP * 16 + row * 16 + h];
            const float mx = fmaxf(l0, fmaxf(l1, l2));
            float w0 = __builtin_amdgcn_exp2f(l0 - mx), w1 = __builtin_amdgcn_exp2f(l1 - mx), w2 = __builtin_amdgcn_exp2f(l2 - mx);
            const float inv = 1.f / (w0 + w1 + w2); w0 *= inv; w1 *= inv; w2 *= inv;
            const u32x4 a0 = *(const u32x4*)(og + row * DM + ch), a1 = *(const u32x4*)(og + (size_t)MP * DM + row * DM + ch), a2 = *(const u32x4*)(og + (size_t)2 * MP * DM + row * DM + ch);
            const u32x4 sg = *(const u32x4*)(qkvg + row * NC + 6144 + ch);
            u32x4 ov;
#pragma unroll
            for (int e = 0; e < 4; ++e) {
                const float lo = (w0 * bflo(a0[e]) + w1 * bflo(a1[e]) + w2 * bflo(a2[e])) * bflo(sg[e]);
                const float hi = (w0 * bfhi(a0[e]) + w1 * bfhi(a1[e]) + w2 * bfhi(a2[e])) * bfhi(sg[e]);
                ov[e] = cvt_pk_bf16(lo, hi);
            }
            *(u32x4*)(zcat + row * DM + ch) = ov;
        }
        __syncthreads();
    }
    for (int st = wid * gridDim.x + blockIdx.x; st < 512; st += 8 * gridDim.x)
        attn_sample_task(p, i, st >> 6, (st >> 4) & 3, st & 15, wl, lane);
}

template <int KIND> __device__ __forceinline__ void gemm_stage(int i, PG8_LAS unsigned char* lds) {
    KP p = getp(); unsigned char* ws = p->ws;
    int G = gridDim.x, c = blockIdx.x; asm volatile("" : "+s"(G), "+s"(c));
    bf16_t* xb = (bf16_t*)(ws + WS_XB); float* hbuf = (float*)(ws + WS_H); float* rss = (float*)(ws + WS_RSS);
    bf16_t* proj = (bf16_t*)(ws + WS_PROJ); bf16_t* zcat = (bf16_t*)(ws + WS_ZCAT);
    if constexpr (KIND == 0) {
        const bf16_t* Wt = (const bf16_t*)(ws + WS_WINAB) + (size_t)i * NAB * DM;
        pg8::Gemm g{xb, Wt, MP, NAB, DM}; pg8::StaticOrder S; S.init(MP, NAB, G, c);
        EpiMain<QInAB> E{{rss + (2 * i) * MT, proj, nullptr}};
        pg8::gemm_phase<EpiMain<QInAB>, pg8::StaticOrder, false>(lds, g, S, E, nullptr);
        skinny_gemm<QInAB>(xb, Wt, NAB, E.q);
    } else if constexpr (KIND == 1) {
        const bf16_t* Wt = (const bf16_t*)(ws + WS_WOUTAB) + (size_t)i * DM * DM;
        pg8::Gemm g{zcat, Wt, MP, DM, DM}; pg8::StaticOrder S; S.init(MP, DM, G, c);
        EpiMain<QOut> E{{i == 0 ? p->in[I_XP] : hbuf, i == 0 ? p->in[I_XS] : hbuf + (size_t)MP * DM, hbuf, xb, rss + (2 * i + 1) * MT}};
        pg8::gemm_phase<EpiMain<QOut>, pg8::StaticOrder, false>(lds, g, S, E, nullptr);
        skinny_gemm<QOut>(zcat, Wt, DM, E.q);
    } else if constexpr (KIND == 2) {
        const bf16_t* Wt = (const bf16_t*)(ws + WS_WINC) + (size_t)i * NC * DM;
        pg8::Gemm g{xb, Wt, MP, NC, DM}; pg8::StaticOrder S; S.init(MP, NC, G, c);
        float* out = p->out;
        EpiMain<QInC> E{{rss + (2 * i + 1) * MT, proj, out + O_KP + (size_t)i * 2 * 2048 * 2048, out + O_KS + (size_t)i * 8 * 2048 * 2048,
                         out + O_VP + (size_t)i * 2 * 2048 * 2048, out + O_VS + (size_t)i * 8 * 2048 * 2048, nullptr}};
        pg8::gemm_phase<EpiMain<QInC>, pg8::StaticOrder, false>(lds, g, S, E, nullptr);
        skinny_gemm<QInC>(xb, Wt, NC, E.q);
    } else {
        const bf16_t* Wt = (const bf16_t*)(ws + WS_WOUTC) + (size_t)i * DM * DM;
        pg8::Gemm g{zcat, Wt, MP, DM, DM}; pg8::StaticOrder S; S.init(MP, DM, G, c);
        EpiMain<QOut> E{{hbuf, hbuf + (size_t)MP * DM, hbuf, xb, rss + (2 * i + 2) * MT}};
        pg8::gemm_phase<EpiMain<QOut>, pg8::StaticOrder, false>(lds, g, S, E, nullptr);
        skinny_gemm<QOut>(zcat, Wt, DM, E.q);
    }
}
__device__ __forceinline__ void final_phase() {
    KP p = getp();
    const float* hbuf = (const float*)(p->ws + WS_H); const float* rss = (const float*)(p->ws + WS_RSS); float* out = p->out;
    const int tid = ltid(), wid = tid >> 6, lane = tid & 63;
    const float* fw = p->in[I_FNW];
    for (int row = blockIdx.x * 8 + wid; row < MT; row += gridDim.x * 8) {
        const float rs = rsqrtf(rss[4 * MT + row] * (1.f / 2048.f) + 1e-6f);
#pragma unroll
        for (int k = 0; k < 8; ++k) {
            const int col = (k * 64 + lane) * 4;
            const f32x4 v = *(const f32x4*)(hbuf + (size_t)row * DM + col), w = *(const f32x4*)(fw + col);
            __builtin_nontemporal_store(v * rs * w, (f32x4*)(out + (size_t)row * DM + col));
        }
    }
}
__global__ void __launch_bounds__(512) hybrid_fwd(Params pdummy) {
    extern __shared__ __attribute__((aligned(16))) unsigned char lds_raw[];
    LAS char* lds = (LAS char*)lds_raw;
    PG8_LAS unsigned char* glds = (PG8_LAS unsigned char*)lds_raw;
    cg::grid_group grid = cg::this_grid();
#ifndef SKIP_P0
    phase0(lds);
#endif
    grid.sync();
    for (int i = 0; i < 2; ++i) {
#ifndef SKIP_G1
        gemm_stage<0>(i, glds);
#endif
        grid.sync();
#ifndef SKIP_MIX
        mixer_phase(i, lds);
#endif
        grid.sync();
#ifndef SKIP_G2
        gemm_stage<1>(i, glds);
#endif
        grid.sync();
#ifndef SKIP_G3
        gemm_stage<2>(i, glds);
#endif
        grid.sync();
#ifndef SKIP_ATT
        attn_phase(i, lds);
#endif
        grid.sync();
#ifndef SKIP_G4
        gemm_stage<3>(i, glds);
#endif
        grid.sync();
    }
    final_phase();
}

extern "C" void kernel_launch(void* const* d_in, const int* in_sizes, int n_in, void* d_out, int out_size, void* d_ws, size_t ws_size, hipStream_t stream) {
    static int grid = 0;
    if (grid == 0) {
        if (n_in != 15 || (size_t)out_size != O_END || ws_size < WS_END) { fprintf(stderr, "kernel_launch: unexpected shapes (n_in %d out %d ws %zu, need %zu / %zu)\n", n_in, out_size, ws_size, (size_t)O_END, (size_t)WS_END); grid = -1; return; }
        int dev = 0, cus = 0, per_cu = 0;
        hipGetDevice(&dev); hipDeviceGetAttribute(&cus, hipDeviceAttributeMultiprocessorCount, dev);
        if (hipFuncSetAttribute((const void*)hybrid_fwd, hipFuncAttributeMaxDynamicSharedMemorySize, LDS_BYTES) != hipSuccess) { fprintf(stderr, "kernel_launch: hipFuncSetAttribute failed\n"); grid = -1; return; }
        if (hipOccupancyMaxActiveBlocksPerMultiprocessor(&per_cu, (const void*)hybrid_fwd, 512, LDS_BYTES) != hipSuccess || per_cu < 1) { fprintf(stderr, "kernel_launch: occupancy query says %d blocks per CU\n", per_cu); (void)hipGetLastError(); grid = -1; return; }
        grid = cus;
    }
    if (grid < 0) return;
    Params prm{};
    for (int i = 0; i < 15; ++i) prm.in[i] = (const float*)d_in[i];
    prm.out = (float*)d_out; prm.ws = (unsigned char*)d_ws;
    void* args[] = {&prm};
    hipError_t e = hipLaunchCooperativeKernel((const void*)hybrid_fwd, dim3(grid), dim3(512), args, LDS_BYTES, stream);
    if (e != hipSuccess) fprintf(stderr, "cooperative launch failed: %s (grid %d)\n", hipGetErrorString(e), grid);
}
```

```cpp
#include <hip/hip_runtime.h>
#include <hip/hip_cooperative_groups.h>
#include <cstdio>
#include <cstdint>
namespace cg = cooperative_groups;
namespace pg8 {
#define PG8_LAS __attribute__((address_space(3)))
typedef unsigned short bf16_t;
typedef short bf16x8 __attribute__((ext_vector_type(8)));
typedef float f32x4 __attribute__((ext_vector_type(4)));
typedef unsigned u32x4 __attribute__((ext_vector_type(4)));
constexpr int BM = 256, BK = 64, HALF = 128, HTB = HALF * BK * 2  , STAGE_BYTES = 8 * HTB, NXCD = 8, WGM = 8;

__host__ __device__ __forceinline__ int lds_byte(int r, int c) { const int st = (r >> 4) * 2 + (c >> 5), rr = r & 15, cc = c & 31, ob = rr * 64 + cc * 2; return st * 1024 + (ob ^ (((ob >> 9) & 1) << 5)); }
__host__ __device__ __forceinline__ void stage_rc(int b, int& R, int& C) { const int st = b / 1024, sb = b % 1024, swz = sb ^ (((sb >> 9) & 1) << 5); R = (st >> 1) * 16 + swz / 64; C = (st & 1) * 32 + (swz % 64) / 2; }
__host__ __device__ __forceinline__ int perm32(int rho) { const int n = rho >> 4, i = rho & 15; return 8 * (i >> 2) + 4 * n + (i & 3); }

struct Unit { int pm, pn; };
struct Gemm { const bf16_t* A; const bf16_t* Bt; int M, N, K; };

struct StaticOrder {
    int nM, nN, nwg, G, c;
    __host__ __device__ void init(int M, int N, int G_, int c_) { nM = M / BM; nN = N / BM; nwg = nM * nN; G = G_; c = c_; }
    __host__ __device__ bool next(int i, Unit& u) const {
        const long L = (long)i * G + c; if (L >= nwg) return false;
        int wgid = (int)L; { const int q = nwg / NXCD, r = nwg % NXCD, xcd = wgid % NXCD, off = wgid / NXCD; wgid = (xcd < r ? xcd * (q + 1) : r * (q + 1) + (xcd - r) * q) + off; }
        const int nig = WGM * nN, gid = wgid / nig, fm = gid * WGM, gsz = (nM - fm) < WGM ? (nM - fm) : WGM;
        u.pm = fm + ((wgid % nig) % gsz); u.pn = (wgid % nig) / gsz; return true;
    }
    __device__ __forceinline__ void a_ready(const Unit&) const {}
    __device__ __forceinline__ void done(const Unit&) const {}
};
__device__ __forceinline__ unsigned cvt_pk_bf16(float lo, float hi) { unsigned r; asm volatile("v_cvt_pk_bf16_f32 %0, %1, %2" : "=v"(r) : "v"(lo), "v"(hi)); return r; }
template <class Epi, class Sched, bool STAMP = false>
__device__ __forceinline__ void gemm_phase(PG8_LAS unsigned char* lds, const Gemm g, const Sched& S, const Epi& E, unsigned long long* stamps) {
    int tid_l = threadIdx.x; asm volatile("" : "+v"(tid_l)); const int tid = tid_l, wid = __builtin_amdgcn_readfirstlane(tid >> 6), lane = tid & 63, wr = wid >> 2, wc = wid & 3, fr = lane & 15, fq = lane >> 4;
    const int K = g.K, nt = K / BK;
    int ts_lo = 0, ts_hi = 0, nts = 0; const unsigned long long rt_entry = STAMP ? (unsigned long long)wall_clock64() : 0ull;
#define PG8_STAMP() do { if (STAMP && wid == 0 && nts < 64) { const unsigned long long _c = (unsigned long long)clock64(); \
        ts_lo = (lane == nts) ? (int)(unsigned)_c : ts_lo; ts_hi = (lane == nts) ? (int)(unsigned)(_c >> 32) : ts_hi; ++nts; } } while (0)
    PG8_STAMP();
    unsigned voffA[2], voffB[2];
#pragma unroll
    for (int i = 0; i < 2; ++i) { int R, C; stage_rc(tid * 16 + i * 8192, R, C); const int Rb = Epi::PERM ? ((R & ~31) + perm32(R & 31)) : R;
        voffA[i] = (unsigned)(R * K + C) * 2u; voffB[i] = (unsigned)(Rb * K + C) * 2u; }
    const size_t kstep = (size_t)(BK * 2);
    const size_t hstep = (size_t)HALF * K * 2;
    const size_t tstep = 2 * hstep;
    const unsigned ldsw = (unsigned)wid * 1024u;
    const int aoff = lds_byte(wr * 64 + fr, fq * 8), boff = lds_byte(wc * 32 + fr, fq * 8);
#define PG8_SA(b, h) (((b) * 2 + (h)) * HTB)
#define PG8_SB(b, h) ((4 + (b) * 2 + (h)) * HTB)
#define PG8_STAGE(bufoff, gbase, voff) do { _Pragma("unroll") for (int _i = 0; _i < 2; ++_i) \
        __builtin_amdgcn_global_load_lds((const unsigned*)((const char*)(gbase) + (voff)[_i]), (PG8_LAS unsigned*)(lds + (bufoff) + ldsw + _i * 8192), 16, 0, 0); } while (0)
#define PG8_LDA(dst, b, h) do { _Pragma("unroll") for (int m = 0; m < 4; ++m) _Pragma("unroll") for (int k = 0; k < 2; ++k) dst[m][k] = *(const PG8_LAS bf16x8*)(lds + PG8_SA(b, h) + aoff + m * 2048 + k * 1024); } while (0)
#define PG8_LDB(dst, b, h) do { _Pragma("unroll") for (int n = 0; n < 2; ++n) _Pragma("unroll") for (int k = 0; k < 2; ++k) dst[n][k] = *(const PG8_LAS bf16x8*)(lds + PG8_SB(b, h) + boff + n * 2048 + k * 1024); } while (0)
#define PG8_MMA(ai, bj, At, Bt) do { __builtin_amdgcn_s_setprio(1); _Pragma("unroll") for (int m = 0; m < 4; ++m) _Pragma("unroll") for (int n = 0; n < 2; ++n) _Pragma("unroll") for (int k = 0; k < 2; ++k) \
        acc[ai][bj][m][n] = __builtin_amdgcn_mfma_f32_16x16x32_bf16(Bt[n][k], At[m][k], acc[ai][bj][m][n], 0, 0, 0); __builtin_amdgcn_s_setprio(0); } while (0)
#define PG8_WAIT_V(n) asm volatile("s_waitcnt vmcnt(" #n ")" ::: "memory")
#define PG8_WAIT_L(n) asm volatile("s_waitcnt lgkmcnt(" #n ")" ::: "memory")
#define PG8_BAR __builtin_amdgcn_s_barrier()
#define PG8_SCHED __builtin_amdgcn_sched_barrier(0)
    Unit cur, nxt; int ui = 0;
    if (!S.next(0, cur)) return;
    f32x4 acc[2][2][4][2];
    if constexpr (Epi::HAS_INIT) E.init(acc, cur, wr, wc, fr, fq); else {
#pragma unroll
    for (int a = 0; a < 2; ++a)
#pragma unroll
        for (int b = 0; b < 2; ++b)
#pragma unroll
            for (int m = 0; m < 4; ++m)
#pragma unroll
                for (int n = 0; n < 2; ++n) acc[a][b][m][n] = (f32x4){0.f, 0.f, 0.f, 0.f};
    }
    bf16x8 At[4][2], B0[2][2], B1[2][2];
    const char* cA = (const char*)g.A + (size_t)cur.pm * tstep; const char* cB = (const char*)g.Bt + (size_t)cur.pn * tstep;
    S.a_ready(cur);
    PG8_STAGE(PG8_SB(0, 0), cB, voffB); PG8_STAGE(PG8_SA(0, 0), cA, voffA); PG8_STAGE(PG8_SB(0, 1), cB + hstep, voffB); PG8_STAGE(PG8_SA(0, 1), cA + hstep, voffA);
    if (wr == 1) PG8_BAR;
    PG8_WAIT_V(4); PG8_BAR;
    PG8_STAGE(PG8_SB(1, 0), cB + kstep, voffB); PG8_STAGE(PG8_SA(1, 0), cA + kstep, voffA); PG8_STAGE(PG8_SB(1, 1), cB + hstep + kstep, voffB);
    PG8_WAIT_V(6); PG8_BAR;
    PG8_STAMP();
    for (;;) {
        const bool has_next = S.next(ui + 1, nxt);
        const char* nA = has_next ? (const char*)g.A + (size_t)nxt.pm * tstep : cA; const char* nB = has_next ? (const char*)g.Bt + (size_t)nxt.pn * tstep : cB;
        for (int t = 0; t < nt; t += 2) {
            const bool last = (t == nt - 2);
            const char* a1 = cA + (size_t)(t + 1) * kstep;
            const char* a2 = last ? nA : cA + (size_t)(t + 2) * kstep; const char* b2 = last ? nB : cB + (size_t)(t + 2) * kstep;
            const char* a3 = a2 + kstep; const char* b3 = b2 + kstep;
            if (last && has_next) S.a_ready(nxt);
            PG8_LDB(B0, 0, 0); PG8_SCHED; PG8_LDA(At, 0, 0); PG8_STAGE(PG8_SA(1, 1), a1 + hstep, voffA);
            PG8_WAIT_L(8); PG8_BAR; PG8_WAIT_L(0); PG8_MMA(0, 0, At, B0); PG8_BAR; PG8_SCHED;
            PG8_LDB(B1, 0, 1); PG8_STAGE(PG8_SB(0, 0), b2, voffB);
            PG8_BAR; PG8_WAIT_L(0); PG8_MMA(0, 1, At, B1); PG8_BAR;
            PG8_LDA(At, 0, 1); PG8_STAGE(PG8_SA(0, 0), a2, voffA);
            PG8_BAR; PG8_WAIT_L(0); PG8_MMA(1, 0, At, B0); PG8_BAR; PG8_SCHED;
            PG8_STAGE(PG8_SB(0, 1), b2 + hstep, voffB);
            PG8_WAIT_V(6); PG8_BAR; PG8_MMA(1, 1, At, B1); PG8_BAR;
            PG8_LDB(B0, 1, 0); PG8_SCHED; PG8_LDA(At, 1, 0); PG8_STAGE(PG8_SA(0, 1), a2 + hstep, voffA);
            PG8_WAIT_L(8); PG8_BAR; PG8_WAIT_L(0); PG8_MMA(0, 0, At, B0); PG8_BAR; PG8_SCHED;
            PG8_LDB(B1, 1, 1); PG8_STAGE(PG8_SB(1, 0), b3, voffB);
            PG8_BAR; PG8_WAIT_L(0); PG8_MMA(0, 1, At, B1); PG8_BAR;
            PG8_LDA(At, 1, 1); PG8_STAGE(PG8_SA(1, 0), a3, voffA);
            PG8_BAR; PG8_WAIT_L(0); PG8_MMA(1, 0, At, B0); PG8_BAR; PG8_SCHED;
            PG8_STAGE(PG8_SB(1, 1), b3 + hstep, voffB);
            PG8_WAIT_V(6); PG8_BAR; PG8_MMA(1, 1, At, B1); PG8_BAR;
        }
        PG8_STAMP();
        if constexpr (!Epi::AFTER_DRAIN) { E(acc, cur, wr, wc, fr, fq); S.done(cur); }
        PG8_STAMP();
        if (!has_next) break;
        if constexpr (Epi::HAS_INIT) E.init(acc, nxt, wr, wc, fr, fq); else {
#pragma unroll
        for (int a = 0; a < 2; ++a)
#pragma unroll
            for (int b = 0; b < 2; ++b)
#pragma unroll
                for (int m = 0; m < 4; ++m)
#pragma unroll
                    for (int n = 0; n < 2; ++n) acc[a][b][m][n] = (f32x4){0.f, 0.f, 0.f, 0.f};
        }
        cur = nxt; cA = nA; cB = nB; ++ui;
    }
    PG8_WAIT_V(0);
    if (wr == 0) PG8_BAR;
    PG8_BAR;
    if constexpr (Epi::AFTER_DRAIN) { E.fused(acc, cur, wr, wc, fr, fq, lds, wid, lane); S.done(cur); }
    PG8_STAMP();
    if (STAMP && wid == 0) { stamps[lane] = lane < nts ? (((unsigned long long)(unsigned)ts_hi << 32) | (unsigned)ts_lo) : 0ull;
        if (lane == 62) stamps[62] = rt_entry; if (lane == 63) stamps[63] = (unsigned long long)wall_clock64(); }
#undef PG8_STAMP
#undef PG8_SA
#undef PG8_SB
#undef PG8_STAGE
#undef PG8_LDA
#undef PG8_LDB
#undef PG8_MMA
#undef PG8_WAIT_V
#undef PG8_WAIT_L
#undef PG8_BAR
#undef PG8_SCHED
}
}

#define LAS __attribute__((address_space(3)))
typedef unsigned short bf16_t;
typedef short bf16x8 __attribute__((ext_vector_type(8)));
typedef short s16x4 __attribute__((ext_vector_type(4)));
typedef short v4i16_t __attribute__((ext_vector_type(4)));
typedef float f32x4 __attribute__((ext_vector_type(4)));
typedef float f32x2 __attribute__((ext_vector_type(2)));
typedef float f32x16 __attribute__((ext_vector_type(16)));
typedef unsigned u32x4 __attribute__((ext_vector_type(4)));
typedef unsigned u32x2 __attribute__((ext_vector_type(2)));
using pg8::cvt_pk_bf16;

#define XB_TMO      128
#define XB_XCNT(j)  (256  + 64 * (j))
#define XB_XSUB(j)  (1280 + 64 * (j))
#define XB_XGEN(j)  (2304 + 64 * (j))
#define XB_TOP      3328
#define XB_TOPGEN   3392
#define XCD_BAR_WORDS 3456
#define XB_SPIN_CAP (1u << 18)

__device__ __forceinline__ unsigned xb_ld(unsigned* p)              { return __hip_atomic_load(p, __ATOMIC_RELAXED, __HIP_MEMORY_SCOPE_AGENT); }
__device__ __forceinline__ unsigned xb_add(unsigned* p, unsigned v) { return __hip_atomic_fetch_add(p, v, __ATOMIC_RELAXED, __HIP_MEMORY_SCOPE_AGENT); }
__device__ __forceinline__ unsigned xb_xcc_id() { return (unsigned)__builtin_amdgcn_s_getreg((3 << 11) | 20) & 0xFu; }
#define XB_SPIN(cond, bar) do { unsigned _sp = 0; while (cond) { __builtin_amdgcn_s_sleep(1); \
    if ((++_sp & 255u) == 0u) { if (xb_ld(&(bar)[XB_TMO])) break; if (_sp > XB_SPIN_CAP) { atomicAdd(&(bar)[XB_TMO], 1u); break; } } } } while (0)

struct XcdBarrier {
    unsigned* bar; unsigned x;
    volatile LAS unsigned* st;
};

__device__ __forceinline__ XcdBarrier xcd_barrier_post(unsigned* bar, volatile LAS unsigned* st) {
    XcdBarrier b; b.bar = bar; b.x = xb_xcc_id(); b.st = st;
    if (threadIdx.x == 0) (void)xb_add(&bar[XB_XCNT(b.x)], 1u);
    return b;
}
__device__ __forceinline__ void xcd_barrier_complete(unsigned* bar, unsigned x, unsigned& nloc, unsigned& nx) {
    const unsigned G = gridDim.x * gridDim.y * gridDim.z;
    unsigned sum, cnt, mine, sp = 0u;
    for (;;) {
        sum = 0u; cnt = 0u; mine = 0u;
#pragma unroll
        for (unsigned j = 0; j < 16; ++j) { const unsigned c = xb_ld(&bar[XB_XCNT(j)]); sum += c; cnt += (c > 0u) ? 1u : 0u; mine = (j == x) ? c : mine; }
        if (sum == G) break;
        __builtin_amdgcn_s_sleep(1);
        if ((++sp & 255u) == 0u) { if (xb_ld(&bar[XB_TMO])) break; if (sp > XB_SPIN_CAP) { atomicAdd(&bar[XB_TMO], 1u); break; } }
    }
    nloc = mine > 0u ? mine : 1u; nx = cnt > 0u ? cnt : 1u;
}

__device__ __forceinline__ void xcd_barrier(const XcdBarrier& b) {
    asm volatile("s_waitcnt vmcnt(0)" ::: "memory");
    __syncthreads();
    if (threadIdx.x == 0) {
        unsigned* bar = b.bar;
        __builtin_amdgcn_s_waitcnt(0);
        unsigned nloc = b.st[0], nx = b.st[1];
        if (nloc == 0u) { xcd_barrier_complete(bar, b.x, nloc, nx); b.st[0] = nloc; b.st[1] = nx; }
        const unsigned old = xb_add(&bar[XB_XSUB(b.x)], 1u);
        const unsigned gen = old / nloc;
        if (old + 1u == (gen + 1u) * nloc) {
            __builtin_amdgcn_fence(__ATOMIC_RELEASE, "agent");
            asm volatile("s_waitcnt vmcnt(0)" ::: "memory");
            const unsigned og = xb_add(&bar[XB_TOP], 1u);
            const unsigned tg = og / nx;
            if (og + 1u == (tg + 1u) * nx) xb_add(&bar[XB_TOPGEN], 1u);
            else XB_SPIN(xb_ld(&bar[XB_TOPGEN]) == tg, bar);
            __builtin_amdgcn_fence(__ATOMIC_ACQUIRE, "agent");
            xb_add(&bar[XB_XGEN(b.x)], 1u);
            asm volatile("s_waitcnt vmcnt(0)" ::: "memory");
        } else {
            XB_SPIN(xb_ld(&bar[XB_XGEN(b.x)]) == gen, bar);
            __builtin_amdgcn_fence(__ATOMIC_ACQUIRE, "agent");
            asm volatile("s_waitcnt vmcnt(0)" ::: "memory");
        }
    }
    __syncthreads();
}

constexpr int DM = 2048, MP = 8192, MS = 32, MT = MP + MS;
constexpr int NAB = 6144, NC = 8192;
constexpr size_t al256(size_t x) { return (x + 255) & ~(size_t)255; }
constexpr size_t WS_XB = 0;
constexpr size_t WS_H = al256(WS_XB + (size_t)MT * DM * 2);
constexpr size_t WS_RSS = al256(WS_H + (size_t)MT * DM * 4);
constexpr size_t WS_PROJ = al256(WS_RSS + (size_t)5 * MT * 4);
constexpr size_t WS_ZCAT = al256(WS_PROJ + (size_t)MT * NC * 2);
constexpr size_t WS_OG = al256(WS_ZCAT + (size_t)MT * DM * 2);
constexpr size_t WS_LSE = al256(WS_OG + (size_t)3 * MP * DM * 2);
constexpr size_t WS_WINAB = al256(WS_LSE + (size_t)3 * MP * 16 * 4);
constexpr size_t WS_WOUTAB = al256(WS_WINAB + (size_t)2 * NAB * DM * 2);
constexpr size_t WS_WINC = al256(WS_WOUTAB + (size_t)2 * DM * DM * 2);
constexpr size_t WS_WOUTC = al256(WS_WINC + (size_t)2 * NC * DM * 2);
constexpr size_t WS_PLIN = al256(WS_WOUTC + (size_t)2 * DM * DM * 2);
constexpr size_t WS_QS = al256(WS_PLIN + (size_t)2 * 4 * 256 * 256 * 2);
constexpr size_t WS_BAR = al256(WS_QS + (size_t)32 * 2048 * 2);
constexpr size_t WS_END = al256(WS_BAR + (size_t)XCD_BAR_WORDS * 4);
constexpr size_t HM = (size_t)2 * 16 * 4096 * 128;
constexpr size_t WS_QH = WS_PROJ, WS_KH = WS_QH + HM * 2, WS_VH = WS_KH + HM * 2, WS_SG = WS_VH + HM * 2;
static_assert(WS_SG + (size_t)MT * DM * 2 <= WS_ZCAT, "C-layer buffers must fit the proj region");
constexpr size_t O_YP = 0, O_YS = O_YP + (size_t)MP * DM, O_PP = O_YS + (size_t)MS * DM, O_PS = O_PP + 2 * 2 * 15 * 1024, O_CP = O_PS + 2 * 8 * 15 * 1024,
                 O_CS = O_CP + 2 * 2 * 2 * 1024, O_KP = O_CS + 2 * 8 * 2 * 1024, O_KS = O_KP + (size_t)2 * 2 * 2048 * 2048, O_VP = O_KS + (size_t)2 * 8 * 2048 * 2048,
                 O_VS = O_VP + (size_t)2 * 2 * 2048 * 2048, O_END = O_VS + (size_t)2 * 8 * 2048 * 2048;
constexpr int LDS_BYTES = 163840;
constexpr int ST_OFF = LDS_BYTES - 16;
constexpr float QSCALE = 0.08838834764831845f * 1.4426950408889634f;

struct Params { const float* in[15]; float* out; unsigned char* ws; };
__device__ __forceinline__ int ltid() { int t = threadIdx.x; asm volatile("" : "+v"(t)); return t; }
__device__ __forceinline__ int lbid() { int t = blockIdx.x; asm volatile("" : "+s"(t)); return t; }
typedef const __attribute__((address_space(4))) Params* KP;
__device__ __forceinline__ KP getp() { KP pp = (KP)__builtin_amdgcn_kernarg_segment_ptr(); asm volatile("" : "+s"(pp)); return pp; }
enum { I_XP = 0, I_XS, I_SPOOL, I_SCONV, I_CK, I_CV, I_NW, I_FNW, I_WINAB, I_PLIN, I_PSCALE, I_CONVW, I_WOUTAB, I_WINC, I_WOUTC };

__device__ __forceinline__ float bf2f(bf16_t b) { return __uint_as_float(((unsigned)b) << 16); }
__device__ __forceinline__ float bflo(unsigned w) { return __uint_as_float(w << 16); }
__device__ __forceinline__ float bfhi(unsigned w) { return __uint_as_float(w & 0xffff0000u); }
__device__ __forceinline__ float silu_f(float x) { return x / (1.f + __expf(-x)); }
__device__ __forceinline__ float wave_sum(float v) {
#pragma unroll
    for (int o = 32; o >= 1; o >>= 1) v += __shfl_xor(v, o);
    return v; }
__device__ __forceinline__ float wave_max(float v) {
#pragma unroll
    for (int o = 32; o >= 1; o >>= 1) v = fmaxf(v, __shfl_xor(v, o));
    return v; }

constexpr int NABO = 4096;
struct QInABtag {}; struct QInAB {
    static constexpr bool NEED_SS = false, RES_EPI = false, INIT = false;
    const float* rss; bf16_t* proj; float* rss_next;
    __device__ __forceinline__ float rowscale(int row) const { return rsqrtf(rss[row] * (1.f / 2048.f) + 1e-6f); }
    __device__ __forceinline__ void pair(int row, int col, f32x4 v0, f32x4 v1, float rs, float& ss) const {
        v0 *= rs; v1 *= rs;
        bf16_t* dst = proj + (size_t)row * NABO;
        if (col < 2048) {
            if (col >= 1024) {
#pragma unroll
                for (int e = 0; e < 4; ++e) { v0[e] = silu_f(v0[e]); v1[e] = silu_f(v1[e]); }
            }
            u32x4 w; w.x = cvt_pk_bf16(v0[0], v0[1]); w.y = cvt_pk_bf16(v0[2], v0[3]); w.z = cvt_pk_bf16(v1[0], v1[1]); w.w = cvt_pk_bf16(v1[2], v1[3]);
            *(u32x4*)(dst + col) = w;
        } else {
            const int second = col >= 4096, ch = ((col - 2048) & 2047) >> 1;
            if (second) {
#pragma unroll
                for (int e = 0; e < 4; ++e) v1[e] = silu_f(v1[e]);
            }
            const f32x4 z = v0 * v1;
            u32x2 w; w.x = cvt_pk_bf16(z[0], z[1]); w.y = cvt_pk_bf16(z[2], z[3]); *(u32x2*)(dst + 2048 + second * 1024 + ch) = w;
        }
    }
    __device__ __forceinline__ void pair_main(int row, int col, f32x4 v0, f32x4 v1, float rs, float& ss) const { pair(row, col, v0, v1, rs, ss); }
};
struct QInC {
    static constexpr bool NEED_SS = false, RES_EPI = false, INIT = false;
    const float* rss; bf16_t* qh; bf16_t* qs; float* kp; float* ks; float* vp; float* vs; float* rss_next;
    __device__ __forceinline__ float rowscale(int row) const { return rsqrtf(rss[row] * (1.f / 2048.f) + 1e-6f); }
    __device__ __forceinline__ void pair(int row, int col, f32x4 v0, f32x4 v1, float rs, float& ss) const {
        v0 *= rs; v1 *= rs;
        const int seg = col >> 11, cc = col & 2047;
        if (seg == 1 || seg == 2) {
            float* dst;
            if (row < MP) { const int b = row >> 12, t = row & 4095; dst = (t >= 2048) ? ((seg == 1 ? kp : vp) + ((size_t)(b * 2048 + (t - 2048)) * 2048 + cc)) : nullptr; }
            else { const int r = row - MP, b = r >> 2, s = r & 3; dst = (seg == 1 ? ks : vs) + ((size_t)(b * 2048 + 2044 + s) * 2048 + cc); }
            if (dst) { __builtin_nontemporal_store(v0, (f32x4*)dst); __builtin_nontemporal_store(v1, (f32x4*)(dst + 4)); }
        }
        if (seg == 0) { v0 *= QSCALE; v1 *= QSCALE; }
        if (seg == 3) {
#pragma unroll
            for (int e = 0; e < 4; ++e) { v0[e] = silu_f(v0[e]); v1[e] = silu_f(v1[e]); }
        }
        u32x4 w; w.x = cvt_pk_bf16(v0[0], v0[1]); w.y = cvt_pk_bf16(v0[2], v0[3]); w.z = cvt_pk_bf16(v1[0], v1[1]); w.w = cvt_pk_bf16(v1[2], v1[3]);
        bf16_t* d2;
        if (seg == 3) d2 = qh + 3 * HM + (size_t)row * DM + cc;
        else if (row < MP) d2 = qh + (size_t)seg * HM + ((size_t)((row >> 12) * 16 + (cc >> 7)) * 4096 + (row & 4095)) * 128 + (cc & 127);
        else d2 = seg == 0 ? qs + (size_t)(row - MP) * DM + cc : nullptr;
        if (d2) *(u32x4*)d2 = w;
    }
    __device__ __forceinline__ void pair_main(int row, int col, f32x4 v0, f32x4 v1, float rs, float& ss) const { pair(row, col, v0, v1, rs, ss); }
};
template <int resb, int wh, int wx> struct QOut {
    static constexpr bool NEED_SS = true, RES_EPI = resb != 0, INIT = resb == 0;
    const float* hold_p; const float* hold_s; float* hbuf; bf16_t* xb; float* rss_next;
    __device__ __forceinline__ float rowscale(int) const { return 1.f; }
    __device__ __forceinline__ u32x4 res_raw(int row, int col) const { return *(const u32x4*)(xb + (size_t)row * DM + col); }
    __device__ __forceinline__ void pair_res(int row, int col, f32x4 v0, f32x4 v1, u32x4 w, float& ss) const {
        pair_main(row, col, v0 + (f32x4){bflo(w.x), bfhi(w.x), bflo(w.y), bfhi(w.y)}, v1 + (f32x4){bflo(w.z), bfhi(w.z), bflo(w.w), bfhi(w.w)}, 1.f, ss); }
    __device__ __forceinline__ void load_res8(int row, int col, f32x4& r0, f32x4& r1) const {
        if (resb) { const u32x4 w = *(const u32x4*)(xb + (size_t)row * DM + col); r0 = (f32x4){bflo(w.x), bfhi(w.x), bflo(w.y), bfhi(w.y)}; r1 = (f32x4){bflo(w.z), bfhi(w.z), bflo(w.w), bfhi(w.w)}; }
        else { const float* src = (row < MP ? hold_p + (size_t)row * DM : hold_s + (size_t)(row - MP) * DM) + col; r0 = *(const f32x4*)src; r1 = *(const f32x4*)(src + 4); }
    }
    __device__ __forceinline__ void pair_main(int row, int col, f32x4 o0, f32x4 o1, float rs, float& ss) const {
        if (wh) { float* hd = hbuf + (size_t)row * DM + col; *(f32x4*)hd = o0; *(f32x4*)(hd + 4) = o1; }
        if (wx) { u32x4 w; w.x = cvt_pk_bf16(o0[0], o0[1]); w.y = cvt_pk_bf16(o0[2], o0[3]); w.z = cvt_pk_bf16(o1[0], o1[1]); w.w = cvt_pk_bf16(o1[2], o1[3]);
                  *(u32x4*)(xb + (size_t)row * DM + col) = w; }
        ss += ((o0[0] * o0[0] + o0[1] * o0[1]) + (o0[2] * o0[2] + o0[3] * o0[3])) + ((o1[0] * o1[0] + o1[1] * o1[1]) + (o1[2] * o1[2] + o1[3] * o1[3]));
    }
    __device__ __forceinline__ void pair(int row, int col, f32x4 v0, f32x4 v1, float rs, float& ss) const { f32x4 r0, r1; load_res8(row, col, r0, r1); pair_main(row, col, r0 + v0, r1 + v1, rs, ss); }
};
constexpr int CP_PER_WG = 130816, CP_PER_EPI = 7680, CP_NJ = 15;
template <class Q> struct EpiMain {
    static constexpr bool PERM = true, AFTER_DRAIN = false, HAS_INIT = Q::INIT;
    Q q; const f32x4* csrc; f32x4* cdst; mutable int seq;
    __device__ __forceinline__ void init(f32x4 (&acc)[2][2][4][2], const pg8::Unit& u, int wr, int wc, int fr, int fq) const {
        if constexpr (HAS_INIT) {
            const int row0 = u.pm * 256 + wr * 64 + fr, col0 = u.pn * 256 + wc * 32 + 8 * fq;
#pragma unroll
            for (int ai = 0; ai < 2; ++ai)
#pragma unroll
                for (int m = 0; m < 4; ++m)
#pragma unroll
                    for (int bj = 0; bj < 2; ++bj) q.load_res8(row0 + ai * 128 + m * 16, col0 + bj * 128, acc[ai][bj][m][0], acc[ai][bj][m][1]);
        }
    }
    __device__ __forceinline__ void operator()(const f32x4 (&acc)[2][2][4][2], const pg8::Unit& u, int wr, int wc, int fr, int fq) const {
        const int row0 = u.pm * 256 + wr * 64 + fr, col0 = u.pn * 256 + wc * 32 + 8 * fq;
        float rsv[2][4];
#pragma unroll
        for (int ai = 0; ai < 2; ++ai)
#pragma unroll
            for (int m = 0; m < 4; ++m) rsv[ai][m] = q.rowscale(row0 + ai * 128 + m * 16);
        asm volatile("" : "+v"(rsv[0][0]), "+v"(rsv[0][1]), "+v"(rsv[0][2]), "+v"(rsv[0][3]), "+v"(rsv[1][0]), "+v"(rsv[1][1]), "+v"(rsv[1][2]), "+v"(rsv[1][3]) :: "memory");
        f32x4 cb[8]; const int cidx = seq * CP_PER_EPI + (wr * 4 + wc) * 64 + fq * 16 + fr;
#define CP_IX(j) ((cidx + (j) * 512) < CP_PER_WG ? (cidx + (j) * 512) : CP_PER_WG - 1)
        if (csrc) {
#pragma unroll
            for (int j = 0; j < 8; ++j) cb[j] = __builtin_nontemporal_load(csrc + CP_IX(j));
        }
#pragma unroll
        for (int ai = 0; ai < 2; ++ai) {
            u32x4 rr[4][2];
            if constexpr (Q::RES_EPI) {
#pragma unroll
                for (int m = 0; m < 4; ++m)
#pragma unroll
                    for (int bj = 0; bj < 2; ++bj) rr[m][bj] = q.res_raw(row0 + ai * 128 + m * 16, col0 + bj * 128);
            }
#pragma unroll
            for (int m = 0; m < 4; ++m) {
                const int row = row0 + ai * 128 + m * 16; const float rs = rsv[ai][m]; float ss = 0.f;
#pragma unroll
                for (int bj = 0; bj < 2; ++bj) {
                    if constexpr (Q::RES_EPI) q.pair_res(row, col0 + bj * 128, acc[ai][bj][m][0], acc[ai][bj][m][1], rr[m][bj], ss);
                    else q.pair_main(row, col0 + bj * 128, acc[ai][bj][m][0], acc[ai][bj][m][1], rs, ss);
                }
                if (Q::NEED_SS) { ss += __shfl_xor(ss, 16); ss += __shfl_xor(ss, 32); if (fq == 0) atomicAdd(q.rss_next + row, ss); }
                asm volatile("" ::: "memory");
            }
            if (csrc) {
                if (ai == 0) {
#pragma unroll
                    for (int j = 0; j < 8; ++j) __builtin_nontemporal_store(cb[j], cdst + CP_IX(j));
#pragma unroll
                    for (int j = 0; j < CP_NJ - 8; ++j) cb[j] = __builtin_nontemporal_load(csrc + CP_IX(8 + j));
                } else {
#pragma unroll
                    for (int j = 0; j < CP_NJ - 8; ++j) __builtin_nontemporal_store(cb[j], cdst + CP_IX(8 + j));
                }
            }
        }
#undef CP_IX
        ++seq;
    }
};
template <class Q> __device__ __forceinline__ void skinny_gemm(const bf16_t* A, const bf16_t* Bt, int N, const Q& q, LAS char* lds) {
    const int tid = ltid(), wid = tid >> 6, lane = tid & 63, fr = lane & 15, fq = lane >> 4;
    const int ntask = N / 32;
    LAS f32x4* part = (LAS f32x4*)lds;
    for (int task = blockIdx.x; task < ntask; task += gridDim.x) {
        const int n0 = task * 32, k0 = wid * 256;
        const bf16_t* a0 = A + (size_t)(MP + fr) * DM + k0 + fq * 8; const bf16_t* a1 = a0 + (size_t)16 * DM;
        const bf16_t* b0 = Bt + (size_t)(n0 + 8 * (fr >> 2) + (fr & 3)) * DM + k0 + fq * 8; const bf16_t* b1 = b0 + (size_t)4 * DM;
        f32x4 c00 = {0.f, 0.f, 0.f, 0.f}, c01 = c00, c10 = c00, c11 = c00;
#pragma unroll
        for (int hk = 0; hk < 2; ++hk) {
            bf16x8 bv0[4], bv1[4], x0[4], x1[4];
#pragma unroll
            for (int kk = 0; kk < 4; ++kk) { const int ko = (hk * 4 + kk) * 32; bv0[kk] = *(const bf16x8*)(b0 + ko); bv1[kk] = *(const bf16x8*)(b1 + ko); x0[kk] = *(const bf16x8*)(a0 + ko); x1[kk] = *(const bf16x8*)(a1 + ko); }
#pragma unroll
            for (int kk = 0; kk < 4; ++kk) {
                c00 = __builtin_amdgcn_mfma_f32_16x16x32_bf16(bv0[kk], x0[kk], c00, 0, 0, 0); c01 = __builtin_amdgcn_mfma_f32_16x16x32_bf16(bv1[kk], x0[kk], c01, 0, 0, 0);
                c10 = __builtin_amdgcn_mfma_f32_16x16x32_bf16(bv0[kk], x1[kk], c10, 0, 0, 0); c11 = __builtin_amdgcn_mfma_f32_16x16x32_bf16(bv1[kk], x1[kk], c11, 0, 0, 0);
            }
        }
        part[(wid * 4 + 0) * 64 + lane] = c00; part[(wid * 4 + 1) * 64 + lane] = c01; part[(wid * 4 + 2) * 64 + lane] = c10; part[(wid * 4 + 3) * 64 + lane] = c11;
        __syncthreads();
        if (wid < 2) {
            f32x4 v0 = part[(wid * 2) * 64 + lane], v1 = part[(wid * 2 + 1) * 64 + lane];
#pragma unroll
            for (int w = 1; w < 8; ++w) { v0 += part[(w * 4 + wid * 2) * 64 + lane]; v1 += part[(w * 4 + wid * 2 + 1) * 64 + lane]; }
            const int row = MP + wid * 16 + fr; const float rs = q.rowscale(row); float ss = 0.f;
            q.pair(row, n0 + 8 * fq, v0, v1, rs, ss);
            if (Q::NEED_SS) { ss += __shfl_xor(ss, 16); ss += __shfl_xor(ss, 32); if (fq == 0) atomicAdd(q.rss_next + row, ss); }
        }
        __syncthreads();
    }
}

__device__ __forceinline__ int ab_dst(int n) {
    if (n < 2048) return n;
    const int seg = n >> 10, ch = n & 1023;
    return ((seg == 3 || seg == 4) ? 2048 : 4096) + (ch >> 2) * 8 + ((seg >= 4) ? 4 : 0) + (ch & 3);
}
__device__ __forceinline__ void conv_tile(const float* W, int ldw, int K, bf16_t* Bt, const float* scale, int k0, int n0, LAS char* lds, bool abmap) {
    constexpr int PITCH = 258;
    LAS bf16_t* T = (LAS bf16_t*)lds;
    const int tid = ltid();
#pragma unroll
    for (int p = 0; p < 8; ++p) {
        const int k = p * 8 + (tid >> 6), c4 = (tid & 63) * 4;
        f32x4 v = __builtin_nontemporal_load((const f32x4*)(W + (size_t)(k0 + k) * ldw + n0 + c4));
        const float s = scale ? scale[k0 + k] : 1.f;
        v *= s;
        LAS unsigned* d = (LAS unsigned*)(T + k * PITCH + c4);
        d[0] = cvt_pk_bf16(v[0], v[1]); d[1] = cvt_pk_bf16(v[2], v[3]);
    }
    __syncthreads();
#pragma unroll
    for (int j = 0; j < 4; ++j) {
        const int ch = tid + j * 512, n = ch >> 3, kc = ch & 7;
        unsigned w[4];
#pragma unroll
        for (int e = 0; e < 4; ++e) { const unsigned lo = T[(kc * 8 + 2 * e) * PITCH + n], hi = T[(kc * 8 + 2 * e + 1) * PITCH + n]; w[e] = lo | (hi << 16); }
        u32x4 o = {w[0], w[1], w[2], w[3]};
        *(u32x4*)(Bt + (size_t)(abmap ? ab_dst(n0 + n) : n0 + n) * K + k0 + kc * 8) = o;
    }
    __syncthreads();
}
__device__ __forceinline__ void phase0(LAS char* lds) {
    KP p = getp();
    const int tid = ltid(), wid = tid >> 6, lane = tid & 63;
    unsigned char* ws = p->ws;
    for (int tile = blockIdx.x; tile < 4640; tile += gridDim.x) {
        const float* W; int ldw, K; bf16_t* Bt; const float* sc; int r;
        if (tile < 4608) {
            const int i = tile / 2304; r = tile % 2304; K = 2048;
            if (r < 768) { W = p->in[I_WINAB] + (size_t)i * DM * NAB; ldw = NAB; Bt = (bf16_t*)(ws + WS_WINAB) + (size_t)i * NAB * DM; sc = p->in[I_NW] + (2 * i) * DM; }
            else if (r < 1024) { r -= 768; W = p->in[I_WOUTAB] + (size_t)i * DM * DM; ldw = DM; Bt = (bf16_t*)(ws + WS_WOUTAB) + (size_t)i * DM * DM; sc = nullptr; }
            else if (r < 2048) { r -= 1024; W = p->in[I_WINC] + (size_t)i * DM * NC; ldw = NC; Bt = (bf16_t*)(ws + WS_WINC) + (size_t)i * NC * DM; sc = p->in[I_NW] + (2 * i + 1) * DM; }
            else { r -= 2048; W = p->in[I_WOUTC] + (size_t)i * DM * DM; ldw = DM; Bt = (bf16_t*)(ws + WS_WOUTC) + (size_t)i * DM * DM; sc = nullptr; }
        } else { const int t2 = tile - 4608, mtx = t2 >> 2; r = t2 & 3; K = 256; ldw = 256; W = p->in[I_PLIN] + (size_t)mtx * 65536; Bt = (bf16_t*)(ws + WS_PLIN) + (size_t)mtx * 65536; sc = nullptr; }
        const int nN = ldw / 256, kt = r / nN, nt = r % nN;
        conv_tile(W, ldw, K, Bt, sc, kt * 64, nt * 256, lds, ldw == NAB);
    }
    float* rss = (float*)(ws + WS_RSS); bf16_t* xb = (bf16_t*)(ws + WS_XB);
    const int gw = blockIdx.x * 8 + wid, nw = gridDim.x * 8;
    for (int row = gw; row < MT; row += nw) {
        const float* src = row < MP ? p->in[I_XP] + (size_t)row * DM : p->in[I_XS] + (size_t)(row - MP) * DM;
        float ss = 0.f;
#pragma unroll
        for (int i = 0; i < 8; ++i) {
            const f32x4 v = *(const f32x4*)(src + (i * 64 + lane) * 4);
            ss += (v[0] * v[0] + v[1] * v[1]) + (v[2] * v[2] + v[3] * v[3]);
            u32x2 w; w.x = cvt_pk_bf16(v[0], v[1]); w.y = cvt_pk_bf16(v[2], v[3]);
            *(u32x2*)(xb + (size_t)row * DM + (i * 64 + lane) * 4) = w;
        }
        ss = wave_sum(ss);
        if (lane == 0) rss[row] = ss;
    }
    const int gtid = blockIdx.x * 512 + tid, nth = gridDim.x * 512;
    for (int i = gtid; i < 4 * MT; i += nth) rss[MT + i] = 0.f;
    if (gridDim.x != 256) {
        constexpr int CH4 = 2044 * 2048 / 4;
        for (int c = 0; c < 32; ++c) { const int kv = c >> 4, ib = c & 15;
            const f32x4* src = (const f32x4*)(p->in[kv ? I_CV : I_CK] + ((size_t)ib * 2048 + 4) * 2048);
            f32x4* dst = (f32x4*)(p->out + (kv ? O_VS : O_KS) + (size_t)ib * 2048 * 2048);
            for (int k = gtid; k < CH4; k += nth) __builtin_nontemporal_store(__builtin_nontemporal_load(src + k), dst + k); }
    }
}

__device__ __forceinline__ void mixer_phase(int i, LAS char* lds) {
    KP p = getp();
    const int tid = ltid(), wid = tid >> 6, lane = tid & 63, fr = lane & 15, fq = lane >> 4;
    unsigned char* ws = p->ws;
    const bf16_t* proj = (const bf16_t*)(ws + WS_PROJ); bf16_t* zcat = (bf16_t*)(ws + WS_ZCAT);
    const bf16_t* plinT = (const bf16_t*)(ws + WS_PLIN) + (size_t)i * 4 * 65536;
    const float* pscale = p->in[I_PSCALE] + i * 1024; const float* convw = p->in[I_CONVW] + i * 3 * 1024;
    constexpr int APITCH = 528;
    constexpr int UROWS = 143, AOFF = 75520;
    for (int task = blockIdx.x; task < 256; task += gridDim.x) {
        const int rt = task >> 2, g = task & 3, b = rt >> 5, t0 = (rt & 31) * 128, kwin = 2 << g;
        const size_t rbase = (size_t)b * 4096;
        const int chunk = tid & 31, rowgrp = tid >> 5;
        {
            const bf16_t* ub = proj + g * 256 + chunk * 8;
#pragma unroll
            for (int j = 0; j < 9; ++j) {
                const int lr = rowgrp + 16 * j;
                if (lr < UROWS) {
                    const int t = t0 - 15 + lr;
                    u32x4 v = {0u, 0u, 0u, 0u};
                    if (t >= 0) v = *(const u32x4*)(ub + (rbase + t) * NABO);
                    *(LAS u32x4*)(lds + lr * APITCH + chunk * 16) = v;
                }
            }
        }
        {
            const int c = g * 256 + chunk * 8;
            f32x4 w0a = *(const f32x4*)(convw + c), w0b = *(const f32x4*)(convw + c + 4), w1a = *(const f32x4*)(convw + 1024 + c), w1b = *(const f32x4*)(convw + 1024 + c + 4),
                  w2a = *(const f32x4*)(convw + 2048 + c), w2b = *(const f32x4*)(convw + 2048 + c + 4);
            const float w0[8] = {w0a[0], w0a[1], w0a[2], w0a[3], w0b[0], w0b[1], w0b[2], w0b[3]};
            const float w1[8] = {w1a[0], w1a[1], w1a[2], w1a[3], w1b[0], w1b[1], w1b[2], w1b[3]};
            const float w2[8] = {w2a[0], w2a[1], w2a[2], w2a[3], w2b[0], w2b[1], w2b[2], w2b[3]};
            float* cpo = p->out + O_CP + ((size_t)(i * 2 + b) * 2) * 1024 + c;
#pragma unroll 4
            for (int j = 0; j < 8; ++j) {
                const int t = t0 + rowgrp + 16 * j; const size_t ro = (rbase + t) * NABO + c;
                const u32x4 z4 = {0u, 0u, 0u, 0u};
                const u32x4 z0 = *(const u32x4*)(proj + ro + 2048);
                const u32x4 z1 = t >= 1 ? *(const u32x4*)(proj + ro - NABO + 2048) : z4;
                const u32x4 z2 = t >= 2 ? *(const u32x4*)(proj + ro - 2 * NABO + 2048) : z4;
                const u32x4 bg = *(const u32x4*)(proj + ro + 3072);
                u32x4 ov;
#pragma unroll
                for (int e = 0; e < 4; ++e) {
                    const float ya = bflo(z2[e]) * w0[2 * e] + bflo(z1[e]) * w1[2 * e] + bflo(z0[e]) * w2[2 * e];
                    const float yb = bfhi(z2[e]) * w0[2 * e + 1] + bfhi(z1[e]) * w1[2 * e + 1] + bfhi(z0[e]) * w2[2 * e + 1];
                    ov[e] = cvt_pk_bf16(bflo(bg[e]) * ya, bfhi(bg[e]) * yb);
                }
                *(u32x4*)(zcat + (rbase + t) * DM + 1024 + c) = ov;
                if (t >= 4094) { float* d = cpo + (size_t)(t - 4094) * 1024; *(f32x4*)d = (f32x4){bflo(z0[0]), bfhi(z0[0]), bflo(z0[1]), bfhi(z0[1])}; *(f32x4*)(d + 4) = (f32x4){bflo(z0[2]), bfhi(z0[2]), bflo(z0[3]), bfhi(z0[3])}; }
            }
        }
        __syncthreads();
        {
            float* pp = p->out + O_PP + ((size_t)(i * 2 + b) * 15) * 1024 + g * 256 + chunk * 8;
#pragma unroll 2
            for (int j = 0; j < 8; ++j) {
                const int lr = rowgrp + 16 * j, t = t0 + lr;
                float sacc[8];
#pragma unroll
                for (int e = 0; e < 8; ++e) sacc[e] = 0.f;
                u32x4 cur = {0u, 0u, 0u, 0u};
                for (int j2 = 0; j2 < kwin; ++j2) {
                    const u32x4 v = *(LAS const u32x4*)(lds + (lr + 15 - j2) * APITCH + chunk * 16);
                    if (j2 == 0) cur = v;
#pragma unroll
                    for (int e = 0; e < 4; ++e) { sacc[2 * e] += bflo(v[e]); sacc[2 * e + 1] += bfhi(v[e]); }
                }
                const float inv = 1.f / fminf((float)kwin, (float)(t + 1));
                u32x4 ov;
#pragma unroll
                for (int e = 0; e < 4; ++e) ov[e] = cvt_pk_bf16(sacc[2 * e] * inv - bflo(cur[e]), sacc[2 * e + 1] * inv - bfhi(cur[e]));
                *(LAS u32x4*)(lds + AOFF + lr * APITCH + chunk * 16) = ov;
                if (t >= 4081) { float* d = pp + (size_t)(t - 4081) * 1024;
                    *(f32x4*)d = (f32x4){bflo(cur[0]), bfhi(cur[0]), bflo(cur[1]), bfhi(cur[1])}; *(f32x4*)(d + 4) = (f32x4){bflo(cur[2]), bfhi(cur[2]), bflo(cur[3]), bfhi(cur[3])}; }
            }
        }
        __syncthreads();
        {
            const int wr = wid >> 2, wc = wid & 3;
            f32x4 acc[4][4];
#pragma unroll
            for (int m = 0; m < 4; ++m)
#pragma unroll
                for (int n = 0; n < 4; ++n) acc[m][n] = (f32x4){0.f, 0.f, 0.f, 0.f};
            const bf16_t* Bg = plinT + (size_t)g * 65536 + (size_t)(wc * 64 + fr) * 256 + fq * 8;
            LAS const char* Al = lds + AOFF + (wr * 64 + fr) * APITCH + fq * 16;
#pragma unroll 2
            for (int ks = 0; ks < 8; ++ks) {
                bf16x8 a[4], bb[4];
#pragma unroll
                for (int m = 0; m < 4; ++m) a[m] = *(LAS const bf16x8*)(Al + m * 16 * APITCH + ks * 64);
#pragma unroll
                for (int n = 0; n < 4; ++n) bb[n] = *(const bf16x8*)(Bg + (size_t)n * 16 * 256 + ks * 32);
#pragma unroll
                for (int m = 0; m < 4; ++m)
#pragma unroll
                    for (int n = 0; n < 4; ++n) acc[m][n] = __builtin_amdgcn_mfma_f32_16x16x32_bf16(bb[n], a[m], acc[m][n], 0, 0, 0);
            }
#pragma unroll
            for (int m = 0; m < 4; ++m) {
                const size_t row = rbase + t0 + wr * 64 + m * 16 + fr;
#pragma unroll
                for (int n = 0; n < 4; ++n) {
                    const int ch = g * 256 + wc * 64 + n * 16 + fq * 4;
                    const f32x4 sc = *(const f32x4*)(pscale + ch);
                    const u32x2 sg = *(const u32x2*)(proj + row * NABO + 1024 + ch);
                    const f32x4 v = acc[m][n] * sc;
                    u32x2 w; w.x = cvt_pk_bf16(v[0] * bflo(sg.x), v[1] * bfhi(sg.x)); w.y = cvt_pk_bf16(v[2] * bflo(sg.y), v[3] * bfhi(sg.y));
                    *(u32x2*)(zcat + row * DM + ch) = w;
                }
            }
        }
        __syncthreads();
    }
    for (int st = blockIdx.x; st < 256; st += gridDim.x) {
        const int b = st >> 5, g = (st >> 3) & 3, dq = st & 7, kwin = 2 << g;
        LAS float* PS = (LAS float*)lds;
        LAS float* RS = PS + 1024;
        if (tid < 256) {
            const int c = g * 256 + tid;
            float ua[19];
            const float* sp = p->in[I_SPOOL] + ((size_t)(i * 8 + b) * 15) * 1024 + c;
#pragma unroll
            for (int j = 0; j < 15; ++j) ua[j] = sp[(size_t)j * 1024];
#pragma unroll
            for (int s = 0; s < 4; ++s) ua[15 + s] = bf2f(proj[(size_t)(MP + b * 4 + s) * NABO + c]);
            const float inv = 1.f / (float)kwin;
#pragma unroll
            for (int s = 0; s < 4; ++s) {
                float a = 0.f;
#pragma unroll
                for (int j = 0; j < 16; ++j) a += (j < kwin) ? ua[15 + s - j] : 0.f;
                PS[s * 256 + tid] = a * inv - ua[15 + s];
            }
            if (dq == 0) {
                float* po = p->out + O_PS + ((size_t)(i * 8 + b) * 15) * 1024 + c;
#pragma unroll
                for (int j = 0; j < 15; ++j) po[(size_t)j * 1024] = ua[4 + j];
            }
        } else if (dq == 0) {
            const int c = g * 256 + (tid - 256);
            const float* scv = p->in[I_SCONV] + ((size_t)(i * 8 + b) * 2) * 1024 + c;
            float za[6]; za[0] = scv[0]; za[1] = scv[1024];
#pragma unroll
            for (int s = 0; s < 4; ++s) za[2 + s] = bf2f(proj[(size_t)(MP + b * 4 + s) * NABO + 2048 + c]);
            const float w0 = convw[c], w1 = convw[1024 + c], w2 = convw[2048 + c];
#pragma unroll
            for (int s = 0; s < 4; ++s) {
                const size_t ro = (size_t)(MP + b * 4 + s) * NABO;
                const float y = za[s] * w0 + za[s + 1] * w1 + za[s + 2] * w2;
                zcat[(size_t)(MP + b * 4 + s) * DM + 1024 + c] = (bf16_t)(cvt_pk_bf16(bf2f(proj[ro + 3072 + c]) * y, 0.f) & 0xffffu);
            }
            float* co = p->out + O_CS + ((size_t)(i * 8 + b) * 2) * 1024 + c;
            co[0] = za[4]; co[1024] = za[5];
        }
        __syncthreads();
        {
            const int dl = tid & 31, s = (tid >> 5) & 3, cs = tid >> 7;
            const float* P = p->in[I_PLIN] + ((size_t)(i * 4 + g) * 256 + cs * 64) * 256 + dq * 32 + dl;
            LAS const float* ps = PS + s * 256 + cs * 64;
            float a = 0.f;
#pragma unroll 16
            for (int c2 = 0; c2 < 64; ++c2) a += ps[c2] * P[(size_t)c2 * 256];
            RS[(cs * 4 + s) * 32 + dl] = a;
        }
        __syncthreads();
        if (tid < 128) {
            const int dl = tid & 31, s = tid >> 5, ch = g * 256 + dq * 32 + dl;
            const float a = (RS[s * 32 + dl] + RS[(4 + s) * 32 + dl]) + (RS[(8 + s) * 32 + dl] + RS[(12 + s) * 32 + dl]);
            const size_t row = (size_t)(MP + b * 4 + s);
            zcat[row * DM + ch] = (bf16_t)(cvt_pk_bf16(a * pscale[ch] * bf2f(proj[row * NABO + 1024 + ch]), 0.f) & 0xffffu);
        }
        __syncthreads();
    }
}

__device__ __forceinline__ int crow(int r, int hi) { return (r & 3) + 8 * (r >> 2) + 4 * hi; }
__device__ __forceinline__ s16x4 vtr(LAS const char* ptr) { return __builtin_bit_cast(s16x4, __builtin_amdgcn_ds_read_tr16_b64_v4i16((LAS v4i16_t*)ptr)); }
#define VM_WAIT(n) asm volatile("s_waitcnt vmcnt(" #n ")" ::: "memory")
#define TR8(base, off, a0, a1, a2, a3, a4, a5, a6, a7) asm volatile( \
    "ds_read_b64_tr_b16 %0, %8 offset:%9\n\tds_read_b64_tr_b16 %1, %8 offset:%9+512\n\tds_read_b64_tr_b16 %2, %8 offset:%9+1024\n\tds_read_b64_tr_b16 %3, %8 offset:%9+1536\n\t" \
    "ds_read_b64_tr_b16 %4, %8 offset:%9+2048\n\tds_read_b64_tr_b16 %5, %8 offset:%9+2560\n\tds_read_b64_tr_b16 %6, %8 offset:%9+3072\n\tds_read_b64_tr_b16 %7, %8 offset:%9+3584\n\t" \
    "s_waitcnt lgkmcnt(0)" \
    : "=&v"(a0), "=&v"(a1), "=&v"(a2), "=&v"(a3), "=&v"(a4), "=&v"(a5), "=&v"(a6), "=&v"(a7) : "v"(base), "i"(off) : "memory")
__device__ __forceinline__ void attn_issue_k(bf16x8 (&kf)[8], const bf16_t* kb, size_t rowb, int mk0, int dil, int lane) {
    const int r32 = lane & 31, hi = lane >> 5;
    const bf16_t* kp = kb + (rowb + (size_t)(mk0 + r32) * dil) * 128 + hi * 8;
#pragma unroll
    for (int d0 = 0; d0 < 8; ++d0) kf[d0] = *(const bf16x8*)(kp + d0 * 16);
}
__device__ __forceinline__ void attn_issue_v(const bf16_t* vb, size_t rowb, int mk0, int dil, LAS char* vbuf, int lane) {
    const bf16_t* vp0 = vb + (rowb + (size_t)(mk0 + (lane >> 2)) * dil) * 128 + (lane & 3) * 8;
    const bf16_t* vp1 = vp0 + (size_t)16 * dil * 128;
#pragma unroll
    for (int ii = 0; ii < 8; ++ii)
        __builtin_amdgcn_global_load_lds((const unsigned*)(((ii & 1) ? vp1 : vp0) + (ii >> 1) * 32), (LAS unsigned*)(vbuf + ii * 1024), 16, 0, 0);
}
__device__ __forceinline__ void attn_wave_task(const bf16_t* qkvg, int b, int h, int dil, int r, int m0, bf16_t* og, float* lse, LAS char* vl, int lane) {
    const int r32 = lane & 31, hi = lane >> 5;
    const size_t hb = (size_t)(b * 16 + h) * 4096 * 128;
    const bf16_t* qb = qkvg + hb, * kb = qkvg + HM + hb, * vb = qkvg + 2 * HM + hb;
    const size_t rowb = (size_t)r;
    const size_t qrow = rowb + (size_t)(m0 + r32) * dil;
    int kt = m0 >= 128 ? 0 : (128 - m0) / 32;
    int par = 0;
    bf16x8 kf[8];
    attn_issue_v(vb, rowb, m0 - 128 + 32 * kt, dil, vl, lane);
    attn_issue_k(kf, kb, rowb, m0 - 128 + 32 * kt, dil, lane);
    bf16x8 qf[8];
#pragma unroll
    for (int d0 = 0; d0 < 8; ++d0) qf[d0] = *(const bf16x8*)(qb + qrow * 128 + d0 * 16 + hi * 8);
    f32x16 o[4];
#pragma unroll
    for (int dt = 0; dt < 4; ++dt)
#pragma unroll
        for (int e = 0; e < 16; ++e) o[dt][e] = 0.f;
    float m_run = -1e30f, l_run = 0.f;
    const int i16 = lane & 15, tq = i16 >> 2, tp = i16 & 3, dblk = (lane >> 4) & 1;
    const unsigned tr0 = (unsigned)(size_t)vl + (4 * hi + tq) * 64 + dblk * 32 + 8 * tp;
    for (;;) {
        const bool hn = kt + 1 < 5;
        f32x16 pt;
#pragma unroll
        for (int e = 0; e < 16; ++e) pt[e] = 0.f;
#pragma unroll
        for (int d0 = 0; d0 < 8; ++d0) pt = __builtin_amdgcn_mfma_f32_32x32x16_bf16(kf[d0], qf[d0], pt, 0, 0, 0);
        asm volatile("" : "+v"(pt) :: "memory");
        if (hn) {
            attn_issue_v(vb, rowb, m0 - 128 + 32 * (kt + 1), dil, vl + (par ^ 1) * 8192, lane);
            attn_issue_k(kf, kb, rowb, m0 - 128 + 32 * (kt + 1), dil, lane);
        }
        asm volatile("" ::: "memory");
        const float NEG = -__builtin_inff();
        if (kt == 0) {
#pragma unroll
            for (int e = 0; e < 16; ++e) if (crow(e, hi) < r32) pt[e] = NEG;
        }
        if (kt == 4) {
#pragma unroll
            for (int e = 0; e < 16; ++e) if (crow(e, hi) > r32) pt[e] = NEG;
        }
        float tmax = pt[0];
#pragma unroll
        for (int e = 1; e < 16; ++e) tmax = fmaxf(tmax, pt[e]);
        { auto rr = __builtin_amdgcn_permlane32_swap(__float_as_uint(tmax), __float_as_uint(tmax), false, false); tmax = fmaxf(__uint_as_float(rr[0]), __uint_as_float(rr[1])); }
        const float mn = fmaxf(m_run, tmax), alpha = __builtin_amdgcn_exp2f(m_run - mn); m_run = mn;
        float ps = 0.f;
#pragma unroll
        for (int e = 0; e < 16; ++e) { pt[e] = __builtin_amdgcn_exp2f(pt[e] - mn); ps += pt[e]; }
        { auto rr = __builtin_amdgcn_permlane32_swap(__float_as_uint(ps), __float_as_uint(ps), false, false); ps = __uint_as_float(rr[0]) + __uint_as_float(rr[1]); }
        l_run = l_run * alpha + ps;
        if (__any(alpha != 1.f)) {
#pragma unroll
            for (int dt = 0; dt < 4; ++dt)
#pragma unroll
                for (int e = 0; e < 16; ++e) o[dt][e] *= alpha;
        }
        bf16x8 pb[2];
#pragma unroll
        for (int s = 0; s < 2; ++s) {
            u32x4 w; w.x = cvt_pk_bf16(pt[8 * s + 0], pt[8 * s + 1]); w.y = cvt_pk_bf16(pt[8 * s + 2], pt[8 * s + 3]); w.z = cvt_pk_bf16(pt[8 * s + 4], pt[8 * s + 5]); w.w = cvt_pk_bf16(pt[8 * s + 6], pt[8 * s + 7]);
            pb[s] = __builtin_bit_cast(bf16x8, w);
        }
        if (hn) VM_WAIT(16); else VM_WAIT(0);
        const unsigned trb = tr0 + par * 8192;
#pragma unroll
        for (int dp = 0; dp < 2; ++dp) {
            s16x4 a0, a1, a2, a3, a4, a5, a6, a7;
            if (dp == 0) TR8(trb, 0, a0, a1, a2, a3, a4, a5, a6, a7); else TR8(trb, 4096, a0, a1, a2, a3, a4, a5, a6, a7);
            o[2 * dp] = __builtin_amdgcn_mfma_f32_32x32x16_bf16(__builtin_shufflevector(a0, a1, 0, 1, 2, 3, 4, 5, 6, 7), pb[0], o[2 * dp], 0, 0, 0);
            o[2 * dp] = __builtin_amdgcn_mfma_f32_32x32x16_bf16(__builtin_shufflevector(a2, a3, 0, 1, 2, 3, 4, 5, 6, 7), pb[1], o[2 * dp], 0, 0, 0);
            o[2 * dp + 1] = __builtin_amdgcn_mfma_f32_32x32x16_bf16(__builtin_shufflevector(a4, a5, 0, 1, 2, 3, 4, 5, 6, 7), pb[0], o[2 * dp + 1], 0, 0, 0);
            o[2 * dp + 1] = __builtin_amdgcn_mfma_f32_32x32x16_bf16(__builtin_shufflevector(a6, a7, 0, 1, 2, 3, 4, 5, 6, 7), pb[1], o[2 * dp + 1], 0, 0, 0);
        }
        if (!hn) break;
        ++kt; par ^= 1;
    }
    const float inv = 1.f / l_run;
    bf16_t* orow = og + hb + qrow * 128 + 4 * hi;
#pragma unroll
    for (int dt = 0; dt < 4; ++dt)
#pragma unroll
        for (int g4 = 0; g4 < 4; ++g4) {
            u32x2 w; w.x = cvt_pk_bf16(o[dt][4 * g4] * inv, o[dt][4 * g4 + 1] * inv); w.y = cvt_pk_bf16(o[dt][4 * g4 + 2] * inv, o[dt][4 * g4 + 3] * inv);
            *(u32x2*)(orow + dt * 32 + 8 * g4) = w;
        }
    if (hi == 0) lse[((size_t)(b * 16 + h) * 4096) + qrow] = m_run + __builtin_amdgcn_logf(l_run);
}
__device__ __forceinline__ void attn_sample_wave(KP p, int i, int b, int s, int h, int g, LAS float* part, int lane) {
    const bf16_t* qs = (const bf16_t*)(p->ws + WS_QS);
    const int kq = lane >> 4, dc = lane & 15, dil = 1 << (2 * g);
    LAS float* sc = part + 136;
    float q8[8];
    { const bf16x8 qv = *(const bf16x8*)(qs + (size_t)(b * 4 + s) * DM + h * 128 + dc * 8);
#pragma unroll
      for (int e = 0; e < 8; ++e) q8[e] = bf2f((bf16_t)qv[e]); }
    const size_t cbase = ((size_t)(i * 8 + b) * 2048) * 2048 + h * 128 + dc * 8;
    const float* ck = p->in[I_CK] + cbase; const float* cv = p->in[I_CV] + cbase;
    const float* kn = p->out + O_KS + cbase + (size_t)2044 * 2048;
    const float* vn = p->out + O_VS + cbase + (size_t)2044 * 2048;
#pragma unroll 1
    for (int bt = 0; bt < 3; ++bt) {
        f32x4 ka[11], kb2[11];
#pragma unroll
        for (int u = 0; u < 11; ++u) {
            const int j = (bt * 11 + u) * 4 + kq, jc = j > 128 ? 128 : j, idx = 2048 + s - dil * jc;
            const float* kr = idx >= 2048 ? kn + (size_t)(idx - 2048) * 2048 : ck + (size_t)idx * 2048;
            ka[u] = *(const f32x4*)kr; kb2[u] = *(const f32x4*)(kr + 4);
        }
#pragma unroll
        for (int u = 0; u < 11; ++u) {
            const int j = (bt * 11 + u) * 4 + kq;
            float d = (ka[u][0] * q8[0] + ka[u][1] * q8[1]) + (ka[u][2] * q8[2] + ka[u][3] * q8[3]) + (kb2[u][0] * q8[4] + kb2[u][1] * q8[5]) + (kb2[u][2] * q8[6] + kb2[u][3] * q8[7]);
            d += __shfl_xor(d, 1); d += __shfl_xor(d, 2); d += __shfl_xor(d, 4); d += __shfl_xor(d, 8);
            if (dc == 0) sc[j] = j <= 128 ? d : -1e30f;
        }
    }
    __builtin_amdgcn_fence(__ATOMIC_RELEASE, "wavefront"); __builtin_amdgcn_wave_barrier();
    float s0 = sc[lane], s1 = sc[lane + 64], s2 = lane < 4 ? sc[lane + 128] : -1e30f;
    const float mx = wave_max(fmaxf(s0, fmaxf(s1, s2)));
    s0 = __builtin_amdgcn_exp2f(s0 - mx); s1 = __builtin_amdgcn_exp2f(s1 - mx); s2 = __builtin_amdgcn_exp2f(s2 - mx);
    const float sum = wave_sum(s0 + s1 + s2);
    sc[lane] = s0; sc[lane + 64] = s1; if (lane < 4) sc[lane + 128] = s2;
    __builtin_amdgcn_fence(__ATOMIC_RELEASE, "wavefront"); __builtin_amdgcn_wave_barrier();
    float o8[8];
#pragma unroll
    for (int e = 0; e < 8; ++e) o8[e] = 0.f;
#pragma unroll 1
    for (int bt = 0; bt < 3; ++bt) {
        f32x4 va[11], vb2[11];
#pragma unroll
        for (int u = 0; u < 11; ++u) {
            const int j = (bt * 11 + u) * 4 + kq, jc = j > 128 ? 128 : j, idx = 2048 + s - dil * jc;
            const float* vr = idx >= 2048 ? vn + (size_t)(idx - 2048) * 2048 : cv + (size_t)idx * 2048;
            va[u] = *(const f32x4*)vr; vb2[u] = *(const f32x4*)(vr + 4);
        }
#pragma unroll
        for (int u = 0; u < 11; ++u) {
            const float pj = sc[(bt * 11 + u) * 4 + kq];
#pragma unroll
            for (int e = 0; e < 4; ++e) { o8[e] += pj * va[u][e]; o8[4 + e] += pj * vb2[u][e]; }
        }
    }
#pragma unroll
    for (int e = 0; e < 8; ++e) { o8[e] += __shfl_xor(o8[e], 16); o8[e] += __shfl_xor(o8[e], 32); }
    if (kq == 0) {
#pragma unroll
        for (int e = 0; e < 8; ++e) part[2 + dc * 8 + e] = o8[e];
    }
    if (lane == 0) { part[0] = mx; part[1] = sum; }
}
__device__ __forceinline__ void attn_phase(int i, LAS char* lds) {
    KP p = getp();
    const int tid = ltid(), wid = __builtin_amdgcn_readfirstlane(tid >> 6), lane = tid & 63;
    const bf16_t* qkvg = (const bf16_t*)(p->ws + WS_PROJ); bf16_t* zcat = (bf16_t*)(p->ws + WS_ZCAT); const bf16_t* sgb = (const bf16_t*)(p->ws + WS_SG);
    bf16_t* og = (bf16_t*)(p->ws + WS_OG); float* lse = (float*)(p->ws + WS_LSE);
    for (int base = blockIdx.x * 2; base < 512; base += gridDim.x * 2) {
        LAS float* parts = (LAS float*)lds;
#ifndef NO_SAMPLE
        if (wid < 6) { const int id = base + wid / 3; attn_sample_wave(p, i, id >> 6, (id >> 4) & 3, id & 15, wid % 3, parts + wid * 272, lane); }
#endif
        __syncthreads();
        if (tid < 256) {
            const int pr = tid >> 7, d = tid & 127, id = base + pr, row = MP + (id >> 6) * 4 + ((id >> 4) & 3), h = id & 15;
            LAS const float* P0 = parts + (pr * 3) * 272, * P1 = P0 + 272, * P2 = P1 + 272;
            const float mx = fmaxf(P0[0], fmaxf(P1[0], P2[0]));
            const float w0 = __builtin_amdgcn_exp2f(P0[0] - mx), w1 = __builtin_amdgcn_exp2f(P1[0] - mx), w2 = __builtin_amdgcn_exp2f(P2[0] - mx);
            const float L = w0 * P0[1] + w1 * P1[1] + w2 * P2[1];
            const float o = (w0 * P0[2 + d] + w1 * P1[2 + d] + w2 * P2[2 + d]) / L;
            const float sg = bf2f(sgb[(size_t)row * DM + h * 128 + d]);
            zcat[(size_t)row * DM + h * 128 + d] = (bf16_t)(cvt_pk_bf16(o * sg, 0.f) & 0xffffu);
        }
        __syncthreads();
    }
    LAS char* wl = lds + wid * 16384;
    {
        const int G = gridDim.x; int xcd, lw, nlw, per;
        if ((G & 7) == 0) { xcd = blockIdx.x & 7; lw = (blockIdx.x >> 3) * 8 + wid; nlw = G; per = 1536; }
        else { xcd = 0; lw = blockIdx.x * 8 + wid; nlw = G * 8; per = 12288; }
#ifdef PROBE_WT2
        for (int rep = 0; rep < 2; ++rep)
#endif
        for (int tau = lw; tau < per; tau += nlw) {
            const int bhi = tau / 384, within = tau - bhi * 384, win = within / 48, tk = within - win * 48;
            const int bh = (per == 1536) ? xcd + 8 * bhi : bhi, b = bh >> 4, h = bh & 15, T0 = win * 512;
            const int g = tk >> 4, sub = tk & 15;
            int dil, r, m0;
            if (g == 0) { dil = 1; r = 0; m0 = T0 + 32 * sub; }
            else if (g == 1) { dil = 4; r = sub & 3; m0 = (T0 >> 2) + 32 * (sub >> 2); }
            else { dil = 16; r = sub; m0 = T0 >> 4; }
#ifndef NO_MAIN
            attn_wave_task(qkvg, b, h, dil, r, m0, og + (size_t)g * HM, lse + (size_t)g * MP * 16, wl, lane);
#endif
        }
    }
}
__device__ __forceinline__ void attn_merge_phase() {
    KP p = getp();
    const int tid = ltid();
    bf16_t* zcat = (bf16_t*)(p->ws + WS_ZCAT); const bf16_t* sgb = (const bf16_t*)(p->ws + WS_SG);
    const bf16_t* og = (const bf16_t*)(p->ws + WS_OG); const float* lse = (const float*)(p->ws + WS_LSE);
    const int nth = gridDim.x * 512;
#pragma unroll 2
    for (int idx = blockIdx.x * 512 + tid; idx < MP * 256; idx += nth) {
        const int row = idx >> 8, chunk = idx & 255, h = chunk >> 4, b = row >> 12, t = row & 4095;
        const size_t li = (size_t)(b * 16 + h) * 4096 + t, oi = li * 128 + (chunk & 15) * 8;
        const float l0 = lse[li], l1 = lse[(size_t)MP * 16 + li], l2 = lse[(size_t)2 * MP * 16 + li];
        const float mx = fmaxf(l0, fmaxf(l1, l2));
        float w0 = __builtin_amdgcn_exp2f(l0 - mx), w1 = __builtin_amdgcn_exp2f(l1 - mx), w2 = __builtin_amdgcn_exp2f(l2 - mx);
        const float inv = 1.f / (w0 + w1 + w2); w0 *= inv; w1 *= inv; w2 *= inv;
        const u32x4 a0 = *(const u32x4*)(og + oi), a1 = *(const u32x4*)(og + HM + oi), a2 = *(const u32x4*)(og + 2 * HM + oi);
        const u32x4 sg = *(const u32x4*)(sgb + (size_t)row * DM + chunk * 8);
        u32x4 ov;
#pragma unroll
        for (int e = 0; e < 4; ++e) {
            const float lo = (w0 * bflo(a0[e]) + w1 * bflo(a1[e]) + w2 * bflo(a2[e])) * bflo(sg[e]);
            const float hi = (w0 * bfhi(a0[e]) + w1 * bfhi(a1[e]) + w2 * bfhi(a2[e])) * bfhi(sg[e]);
            ov[e] = cvt_pk_bf16(lo, hi);
        }
        *(u32x4*)(zcat + (size_t)row * DM + chunk * 8) = ov;
    }
}

template <int KIND> __device__ __forceinline__ void gemm_stage(int i, PG8_LAS unsigned char* lds) {
    KP p = getp(); unsigned char* ws = p->ws;
    int G = gridDim.x, c = blockIdx.x; asm volatile("" : "+s"(G), "+s"(c));
    bf16_t* xb = (bf16_t*)(ws + WS_XB); float* hbuf = (float*)(ws + WS_H); float* rss = (float*)(ws + WS_RSS);
    bf16_t* proj = (bf16_t*)(ws + WS_PROJ); bf16_t* zcat = (bf16_t*)(ws + WS_ZCAT);
    const f32x4* csrc = nullptr; f32x4* cdst = nullptr;
    if (G == 256) { const int chunk = c >> 3, part = c & 7, kv = chunk >> 4, ib = chunk & 15;
        csrc = (const f32x4*)(p->in[kv ? I_CV : I_CK] + ((size_t)ib * 2048 + 4) * 2048) + (size_t)part * CP_PER_WG;
        cdst = (f32x4*)(p->out + (kv ? O_VS : O_KS) + (size_t)ib * 2048 * 2048) + (size_t)part * CP_PER_WG; }
    const int seq0 = i * 9 + (KIND == 0 ? 0 : KIND == 1 ? 3 : KIND == 2 ? 4 : 8);
#ifdef STAGGER_TICKS
    if ((KIND == 0 || KIND == 2) && (c & 1)) {
        const unsigned long long t0 = __builtin_amdgcn_s_memrealtime();
        while (__builtin_amdgcn_s_memrealtime() - t0 < STAGGER_TICKS) __builtin_amdgcn_s_sleep(8);
    }
#endif
    if constexpr (KIND == 0) {
        const bf16_t* Wt = (const bf16_t*)(ws + WS_WINAB) + (size_t)i * NAB * DM;
        pg8::Gemm g{xb, Wt, MP, NAB, DM}; pg8::StaticOrder S; S.init(MP, NAB, G, c);
        EpiMain<QInAB> E{{rss + (2 * i) * MT, proj, nullptr}, csrc, cdst, seq0};
        pg8::gemm_phase<EpiMain<QInAB>, pg8::StaticOrder, false>(lds, g, S, E, nullptr);
        skinny_gemm<QInAB>(xb, Wt, NAB, E.q, (LAS char*)lds);
    } else if constexpr (KIND == 1) {
        const bf16_t* Wt = (const bf16_t*)(ws + WS_WOUTAB) + (size_t)i * DM * DM;
        pg8::Gemm g{zcat, Wt, MP, DM, DM}; pg8::StaticOrder S; S.init(MP, DM, G, c);
        if (i == 0) { typedef QOut<0, 0, 1> QT; EpiMain<QT> E{{p->in[I_XP], p->in[I_XS], hbuf, xb, rss + (2 * i + 1) * MT}, csrc, cdst, seq0};
            pg8::gemm_phase<EpiMain<QT>, pg8::StaticOrder, false>(lds, g, S, E, nullptr); skinny_gemm<QT>(zcat, Wt, DM, E.q, (LAS char*)lds); }
        else { typedef QOut<1, 0, 1> QT; EpiMain<QT> E{{nullptr, nullptr, hbuf, xb, rss + (2 * i + 1) * MT}, csrc, cdst, seq0};
            pg8::gemm_phase<EpiMain<QT>, pg8::StaticOrder, false>(lds, g, S, E, nullptr); skinny_gemm<QT>(zcat, Wt, DM, E.q, (LAS char*)lds); }
    } else if constexpr (KIND == 2) {
        const bf16_t* Wt = (const bf16_t*)(ws + WS_WINC) + (size_t)i * NC * DM;
        pg8::Gemm g{xb, Wt, MP, NC, DM}; pg8::StaticOrder S; S.init(MP, NC, G, c);
        float* out = p->out;
        EpiMain<QInC> E{{rss + (2 * i + 1) * MT, proj, (bf16_t*)(ws + WS_QS), out + O_KP + (size_t)i * 2 * 2048 * 2048, out + O_KS + (size_t)i * 8 * 2048 * 2048,
                         out + O_VP + (size_t)i * 2 * 2048 * 2048, out + O_VS + (size_t)i * 8 * 2048 * 2048, nullptr}, csrc, cdst, seq0};
        pg8::gemm_phase<EpiMain<QInC>, pg8::StaticOrder, false>(lds, g, S, E, nullptr);
        skinny_gemm<QInC>(xb, Wt, NC, E.q, (LAS char*)lds);
    } else {
        const bf16_t* Wt = (const bf16_t*)(ws + WS_WOUTC) + (size_t)i * DM * DM;
        pg8::Gemm g{zcat, Wt, MP, DM, DM}; pg8::StaticOrder S; S.init(MP, DM, G, c);
        if (i == 0) { typedef QOut<1, 0, 1> QT; EpiMain<QT> E{{nullptr, nullptr, hbuf, xb, rss + (2 * i + 2) * MT}, csrc, cdst, seq0};
            pg8::gemm_phase<EpiMain<QT>, pg8::StaticOrder, false>(lds, g, S, E, nullptr); skinny_gemm<QT>(zcat, Wt, DM, E.q, (LAS char*)lds); }
        else { typedef QOut<1, 1, 0> QT; EpiMain<QT> E{{nullptr, nullptr, hbuf, xb, rss + (2 * i + 2) * MT}, csrc, cdst, seq0};
            pg8::gemm_phase<EpiMain<QT>, pg8::StaticOrder, false>(lds, g, S, E, nullptr); skinny_gemm<QT>(zcat, Wt, DM, E.q, (LAS char*)lds); }
    }
}
__device__ __forceinline__ void final_phase() {
    KP p = getp();
    const float* hbuf = (const float*)(p->ws + WS_H); const float* rss = (const float*)(p->ws + WS_RSS); float* out = p->out;
    const int tid = ltid(), wid = tid >> 6, lane = tid & 63;
    const float* fw = p->in[I_FNW];
    for (int row = blockIdx.x * 8 + wid; row < MT; row += gridDim.x * 8) {
        const float rs = rsqrtf(rss[4 * MT + row] * (1.f / 2048.f) + 1e-6f);
#pragma unroll
        for (int k = 0; k < 8; ++k) {
            const int col = (k * 64 + lane) * 4;
            const f32x4 v = *(const f32x4*)(hbuf + (size_t)row * DM + col), w = *(const f32x4*)(fw + col);
            __builtin_nontemporal_store(v * rs * w, (f32x4*)(out + (size_t)row * DM + col));
        }
    }
}
__device__ __forceinline__ void gsync_xcd(LAS char* lds) {
    KP p = getp();
    XcdBarrier b; b.bar = (unsigned*)(p->ws + WS_BAR); b.x = xb_xcc_id(); b.st = (volatile LAS unsigned*)(lds + ST_OFF);
    xcd_barrier(b);
}
#define GSYNC() gsync_xcd(lds)
__global__ void __launch_bounds__(512) hybrid_fwd(Params pdummy) {
    extern __shared__ __attribute__((aligned(16))) unsigned char lds_raw[];
    LAS char* lds = (LAS char*)lds_raw;
    PG8_LAS unsigned char* glds = (PG8_LAS unsigned char*)lds_raw;
    cg::grid_group grid = cg::this_grid();
    {
        if (threadIdx.x == 0) { ((volatile LAS unsigned*)(lds + ST_OFF))[0] = 0u; ((volatile LAS unsigned*)(lds + ST_OFF))[1] = 0u; }
        __syncthreads();
        KP p0 = getp();
        (void)xcd_barrier_post((unsigned*)(p0->ws + WS_BAR), (volatile LAS unsigned*)(lds + ST_OFF));
    }
#ifndef SKIP_P0
    phase0(lds);
#ifdef PROBE_P02
    GSYNC(); phase0(lds);
#endif
#endif
    GSYNC();
    if (__builtin_expect(gridDim.y > 1u, 0)) grid.sync();
    for (int i = 0; i < 2; ++i) {
#ifndef SKIP_G1
        gemm_stage<0>(i, glds);
#ifdef PROBE_G2X
        GSYNC(); gemm_stage<0>(i, glds);
#endif
#endif
        GSYNC();
#ifndef SKIP_MIX
        mixer_phase(i, lds);
#ifdef PROBE_MIX2
        GSYNC(); mixer_phase(i, lds);
#endif
#endif
        GSYNC();
#ifndef SKIP_G2
        gemm_stage<1>(i, glds);
#endif
        GSYNC();
#ifndef SKIP_G3
        gemm_stage<2>(i, glds);
#ifdef PROBE_G2X
        GSYNC(); gemm_stage<2>(i, glds);
#endif
#endif
        GSYNC();
#ifndef SKIP_ATT
        attn_phase(i, lds);
        GSYNC();
        attn_merge_phase();
#endif
        GSYNC();
#ifndef SKIP_G4
        gemm_stage<3>(i, glds);
#endif
        GSYNC();
    }
    final_phase();
}

extern "C" void kernel_launch(void* const* d_in, const int* in_sizes, int n_in, void* d_out, int out_size, void* d_ws, size_t ws_size, hipStream_t stream) {
    static int grid = 0;
    if (grid == 0) {
        if (n_in != 15 || (size_t)out_size != O_END || ws_size < WS_END) { fprintf(stderr, "kernel_launch: unexpected shapes (n_in %d out %d ws %zu, need %zu / %zu)\n", n_in, out_size, ws_size, (size_t)O_END, (size_t)WS_END); grid = -1; return; }
        int dev = 0, cus = 0, per_cu = 0;
        hipGetDevice(&dev); hipDeviceGetAttribute(&cus, hipDeviceAttributeMultiprocessorCount, dev);
        if (hipFuncSetAttribute((const void*)hybrid_fwd, hipFuncAttributeMaxDynamicSharedMemorySize, LDS_BYTES) != hipSuccess) { fprintf(stderr, "kernel_launch: hipFuncSetAttribute failed\n"); grid = -1; return; }
        if (hipOccupancyMaxActiveBlocksPerMultiprocessor(&per_cu, (const void*)hybrid_fwd, 512, LDS_BYTES) != hipSuccess || per_cu < 1) { fprintf(stderr, "kernel_launch: occupancy query says %d blocks per CU\n", per_cu); (void)hipGetLastError(); grid = -1; return; }
        grid = cus;
    }
    if (grid < 0) return;
    Params prm{};
    for (int i = 0; i < 15; ++i) prm.in[i] = (const float*)d_in[i];
    prm.out = (float*)d_out; prm.ws = (unsigned char*)d_ws;
    if (hipMemsetAsync((char*)d_ws + WS_BAR, 0, (size_t)XCD_BAR_WORDS * 4, stream) != hipSuccess) { fprintf(stderr, "kernel_launch: memset of the barrier words failed\n"); return; }
    void* args[] = {&prm};
    hipError_t e = hipLaunchCooperativeKernel((const void*)hybrid_fwd, dim3(grid), dim3(512), args, LDS_BYTES, stream);
    if (e != hipSuccess) fprintf(stderr, "cooperative launch failed: %s (grid %d)\n", hipGetErrorString(e), grid);
}
```

```cpp
#include <hip/hip_runtime.h>
#include <hip/hip_cooperative_groups.h>
#include <cstdio>
#include <cstdint>
namespace cg = cooperative_groups;
namespace pg8 {
#define PG8_LAS __attribute__((address_space(3)))
typedef unsigned short bf16_t;
typedef short bf16x8 __attribute__((ext_vector_type(8)));
typedef float f32x4 __attribute__((ext_vector_type(4)));
typedef unsigned u32x4 __attribute__((ext_vector_type(4)));
constexpr int BM = 256, BK = 64, HALF = 128, HTB = HALF * BK * 2  , STAGE_BYTES = 8 * HTB, NXCD = 8, WGM = 8;

__host__ __device__ __forceinline__ int lds_byte(int r, int c) { const int st = (r >> 4) * 2 + (c >> 5), rr = r & 15, cc = c & 31, ob = rr * 64 + cc * 2; return st * 1024 + (ob ^ (((ob >> 9) & 1) << 5)); }
__host__ __device__ __forceinline__ void stage_rc(int b, int& R, int& C) { const int st = b / 1024, sb = b % 1024, swz = sb ^ (((sb >> 9) & 1) << 5); R = (st >> 1) * 16 + swz / 64; C = (st & 1) * 32 + (swz % 64) / 2; }
__host__ __device__ __forceinline__ int perm32(int rho) { const int n = rho >> 4, i = rho & 15; return 8 * (i >> 2) + 4 * n + (i & 3); }

struct Unit { int pm, pn; };
struct Gemm { const bf16_t* A; const bf16_t* Bt; int M, N, K; };

struct StaticOrder {
    int nM, nN, nwg, G, c;
    __host__ __device__ void init(int M, int N, int G_, int c_) { nM = M / BM; nN = N / BM; nwg = nM * nN; G = G_; c = c_; }
    __host__ __device__ bool next(int i, Unit& u) const {
        const long L = (long)i * G + c; if (L >= nwg) return false;
        int wgid = (int)L; { const int q = nwg / NXCD, r = nwg % NXCD, xcd = wgid % NXCD, off = wgid / NXCD; wgid = (xcd < r ? xcd * (q + 1) : r * (q + 1) + (xcd - r) * q) + off; }
        const int nig = WGM * nN, gid = wgid / nig, fm = gid * WGM, gsz = (nM - fm) < WGM ? (nM - fm) : WGM;
        u.pm = fm + ((wgid % nig) % gsz); u.pn = (wgid % nig) / gsz; return true;
    }
    __device__ __forceinline__ void a_ready(const Unit&) const {}
    __device__ __forceinline__ void done(const Unit&) const {}
};
__device__ __forceinline__ unsigned cvt_pk_bf16(float lo, float hi) { unsigned r; asm volatile("v_cvt_pk_bf16_f32 %0, %1, %2" : "=v"(r) : "v"(lo), "v"(hi)); return r; }
template <class Epi, class Sched, bool STAMP = false>
__device__ __forceinline__ void gemm_phase(PG8_LAS unsigned char* lds, const Gemm g, const Sched& S, const Epi& E, unsigned long long* stamps) {
    int tid_l = threadIdx.x; asm volatile("" : "+v"(tid_l)); const int tid = tid_l, wid = __builtin_amdgcn_readfirstlane(tid >> 6), lane = tid & 63, wr = wid >> 2, wc = wid & 3, fr = lane & 15, fq = lane >> 4;
    const int K = g.K, nt = K / BK;
    int ts_lo = 0, ts_hi = 0, nts = 0; const unsigned long long rt_entry = STAMP ? (unsigned long long)wall_clock64() : 0ull;
#define PG8_STAMP() do { if (STAMP && wid == 0 && nts < 64) { const unsigned long long _c = (unsigned long long)clock64(); \
        ts_lo = (lane == nts) ? (int)(unsigned)_c : ts_lo; ts_hi = (lane == nts) ? (int)(unsigned)(_c >> 32) : ts_hi; ++nts; } } while (0)
    PG8_STAMP();
    unsigned voffA[2], voffB[2];
#pragma unroll
    for (int i = 0; i < 2; ++i) { int R, C; stage_rc(tid * 16 + i * 8192, R, C); const int Rb = Epi::PERM ? ((R & ~31) + perm32(R & 31)) : R;
        voffA[i] = (unsigned)(R * K + C) * 2u; voffB[i] = (unsigned)(Rb * K + C) * 2u; }
    const size_t kstep = (size_t)(BK * 2);
    const size_t hstep = (size_t)HALF * K * 2;
    const size_t tstep = 2 * hstep;
    const unsigned ldsw = (unsigned)wid * 1024u;
    const int aoff = lds_byte(wr * 64 + fr, fq * 8), boff = lds_byte(wc * 32 + fr, fq * 8);
#define PG8_SA(b, h) (((b) * 2 + (h)) * HTB)
#define PG8_SB(b, h) ((4 + (b) * 2 + (h)) * HTB)
#define PG8_STAGE(bufoff, gbase, voff) do { _Pragma("unroll") for (int _i = 0; _i < 2; ++_i) \
        __builtin_amdgcn_global_load_lds((const unsigned*)((const char*)(gbase) + (voff)[_i]), (PG8_LAS unsigned*)(lds + (bufoff) + ldsw + _i * 8192), 16, 0, 0); } while (0)
#define PG8_LDA(dst, b, h) do { _Pragma("unroll") for (int m = 0; m < 4; ++m) _Pragma("unroll") for (int k = 0; k < 2; ++k) dst[m][k] = *(const PG8_LAS bf16x8*)(lds + PG8_SA(b, h) + aoff + m * 2048 + k * 1024); } while (0)
#define PG8_LDB(dst, b, h) do { _Pragma("unroll") for (int n = 0; n < 2; ++n) _Pragma("unroll") for (int k = 0; k < 2; ++k) dst[n][k] = *(const PG8_LAS bf16x8*)(lds + PG8_SB(b, h) + boff + n * 2048 + k * 1024); } while (0)
#define PG8_MMA(ai, bj, At, Bt) do { __builtin_amdgcn_s_setprio(1); _Pragma("unroll") for (int m = 0; m < 4; ++m) _Pragma("unroll") for (int n = 0; n < 2; ++n) _Pragma("unroll") for (int k = 0; k < 2; ++k) \
        acc[ai][bj][m][n] = __builtin_amdgcn_mfma_f32_16x16x32_bf16(Bt[n][k], At[m][k], acc[ai][bj][m][n], 0, 0, 0); __builtin_amdgcn_s_setprio(0); } while (0)
#define PG8_WAIT_V(n) asm volatile("s_waitcnt vmcnt(" #n ")" ::: "memory")
#define PG8_WAIT_L(n) asm volatile("s_waitcnt lgkmcnt(" #n ")" ::: "memory")
#define PG8_BAR __builtin_amdgcn_s_barrier()
#define PG8_SCHED __builtin_amdgcn_sched_barrier(0)
    Unit cur, nxt; int ui = 0;
    if (!S.next(0, cur)) return;
    f32x4 acc[2][2][4][2];
    if constexpr (Epi::HAS_INIT) E.init(acc, cur, wr, wc, fr, fq); else {
#pragma unroll
    for (int a = 0; a < 2; ++a)
#pragma unroll
        for (int b = 0; b < 2; ++b)
#pragma unroll
            for (int m = 0; m < 4; ++m)
#pragma unroll
                for (int n = 0; n < 2; ++n) acc[a][b][m][n] = (f32x4){0.f, 0.f, 0.f, 0.f};
    }
    bf16x8 At[4][2], B0[2][2], B1[2][2];
    const char* cA = (const char*)g.A + (size_t)cur.pm * tstep; const char* cB = (const char*)g.Bt + (size_t)cur.pn * tstep;
    S.a_ready(cur);
    PG8_STAGE(PG8_SB(0, 0), cB, voffB); PG8_STAGE(PG8_SA(0, 0), cA, voffA); PG8_STAGE(PG8_SB(0, 1), cB + hstep, voffB); PG8_STAGE(PG8_SA(0, 1), cA + hstep, voffA);
    if (wr == 1) PG8_BAR;
    PG8_WAIT_V(4); PG8_BAR;
    PG8_STAGE(PG8_SB(1, 0), cB + kstep, voffB); PG8_STAGE(PG8_SA(1, 0), cA + kstep, voffA); PG8_STAGE(PG8_SB(1, 1), cB + hstep + kstep, voffB);
    PG8_WAIT_V(6); PG8_BAR;
    PG8_STAMP();
    for (;;) {
        const bool has_next = S.next(ui + 1, nxt);
        const char* nA = has_next ? (const char*)g.A + (size_t)nxt.pm * tstep : cA; const char* nB = has_next ? (const char*)g.Bt + (size_t)nxt.pn * tstep : cB;
        for (int t = 0; t < nt; t += 2) {
            const bool last = (t == nt - 2);
            const char* a1 = cA + (size_t)(t + 1) * kstep;
            const char* a2 = last ? nA : cA + (size_t)(t + 2) * kstep; const char* b2 = last ? nB : cB + (size_t)(t + 2) * kstep;
            const char* a3 = a2 + kstep; const char* b3 = b2 + kstep;
            if (last && has_next) S.a_ready(nxt);
            PG8_LDB(B0, 0, 0); PG8_SCHED; PG8_LDA(At, 0, 0); PG8_STAGE(PG8_SA(1, 1), a1 + hstep, voffA);
            PG8_WAIT_L(8); PG8_BAR; PG8_WAIT_L(0); PG8_MMA(0, 0, At, B0); PG8_BAR; PG8_SCHED;
            PG8_LDB(B1, 0, 1); PG8_STAGE(PG8_SB(0, 0), b2, voffB);
            PG8_BAR; PG8_WAIT_L(0); PG8_MMA(0, 1, At, B1); PG8_BAR;
            PG8_LDA(At, 0, 1); PG8_STAGE(PG8_SA(0, 0), a2, voffA);
            PG8_BAR; PG8_WAIT_L(0); PG8_MMA(1, 0, At, B0); PG8_BAR; PG8_SCHED;
            PG8_STAGE(PG8_SB(0, 1), b2 + hstep, voffB);
            PG8_WAIT_V(6); PG8_BAR; PG8_MMA(1, 1, At, B1); PG8_BAR;
            PG8_LDB(B0, 1, 0); PG8_SCHED; PG8_LDA(At, 1, 0); PG8_STAGE(PG8_SA(0, 1), a2 + hstep, voffA);
            PG8_WAIT_L(8); PG8_BAR; PG8_WAIT_L(0); PG8_MMA(0, 0, At, B0); PG8_BAR; PG8_SCHED;
            PG8_LDB(B1, 1, 1); PG8_STAGE(PG8_SB(1, 0), b3, voffB);
            PG8_BAR; PG8_WAIT_L(0); PG8_MMA(0, 1, At, B1); PG8_BAR;
            PG8_LDA(At, 1, 1); PG8_STAGE(PG8_SA(1, 0), a3, voffA);
            PG8_BAR; PG8_WAIT_L(0); PG8_MMA(1, 0, At, B0); PG8_BAR; PG8_SCHED;
            PG8_STAGE(PG8_SB(1, 1), b3 + hstep, voffB);
            PG8_WAIT_V(6); PG8_BAR; PG8_MMA(1, 1, At, B1); PG8_BAR;
        }
        PG8_STAMP();
        if constexpr (!Epi::AFTER_DRAIN) { E(acc, cur, wr, wc, fr, fq); S.done(cur); }
        PG8_STAMP();
        if (!has_next) break;
        if constexpr (Epi::HAS_INIT) E.init(acc, nxt, wr, wc, fr, fq); else {
#pragma unroll
        for (int a = 0; a < 2; ++a)
#pragma unroll
            for (int b = 0; b < 2; ++b)
#pragma unroll
                for (int m = 0; m < 4; ++m)
#pragma unroll
                    for (int n = 0; n < 2; ++n) acc[a][b][m][n] = (f32x4){0.f, 0.f, 0.f, 0.f};
        }
        cur = nxt; cA = nA; cB = nB; ++ui;
    }
    PG8_WAIT_V(0);
    if (wr == 0) PG8_BAR;
    PG8_BAR;
    if constexpr (Epi::AFTER_DRAIN) { E.fused(acc, cur, wr, wc, fr, fq, lds, wid, lane); S.done(cur); }
    PG8_STAMP();
    if (STAMP && wid == 0) { stamps[lane] = lane < nts ? (((unsigned long long)(unsigned)ts_hi << 32) | (unsigned)ts_lo) : 0ull;
        if (lane == 62) stamps[62] = rt_entry; if (lane == 63) stamps[63] = (unsigned long long)wall_clock64(); }
#undef PG8_STAMP
#undef PG8_SA
#undef PG8_SB
#undef PG8_STAGE
#undef PG8_LDA
#undef PG8_LDB
#undef PG8_MMA
#undef PG8_WAIT_V
#undef PG8_WAIT_L
#undef PG8_BAR
#undef PG8_SCHED
}
}

#define LAS __attribute__((address_space(3)))
typedef unsigned short bf16_t;
typedef short bf16x8 __attribute__((ext_vector_type(8)));
typedef short s16x4 __attribute__((ext_vector_type(4)));
typedef short v4i16_t __attribute__((ext_vector_type(4)));
typedef float f32x4 __attribute__((ext_vector_type(4)));
typedef float f32x2 __attribute__((ext_vector_type(2)));
typedef float f32x16 __attribute__((ext_vector_type(16)));
typedef unsigned u32x4 __attribute__((ext_vector_type(4)));
typedef unsigned u32x2 __attribute__((ext_vector_type(2)));
using pg8::cvt_pk_bf16;

#define XB_TMO      128
#define XB_XCNT(j)  (256  + 64 * (j))
#define XB_XSUB(j)  (1280 + 64 * (j))
#define XB_XGEN(j)  (2304 + 64 * (j))
#define XB_TOP      3328
#define XB_TOPGEN   3392
#define XCD_BAR_WORDS 3456
#define XB_SPIN_CAP (1u << 18)

__device__ __forceinline__ unsigned xb_ld(unsigned* p)              { return __hip_atomic_load(p, __ATOMIC_RELAXED, __HIP_MEMORY_SCOPE_AGENT); }
__device__ __forceinline__ unsigned xb_add(unsigned* p, unsigned v) { return __hip_atomic_fetch_add(p, v, __ATOMIC_RELAXED, __HIP_MEMORY_SCOPE_AGENT); }
__device__ __forceinline__ unsigned xb_xcc_id() { return (unsigned)__builtin_amdgcn_s_getreg((3 << 11) | 20) & 0xFu; }
#define XB_SPIN(cond, bar) do { unsigned _sp = 0; while (cond) { __builtin_amdgcn_s_sleep(1); \
    if ((++_sp & 255u) == 0u) { if (xb_ld(&(bar)[XB_TMO])) break; if (_sp > XB_SPIN_CAP) { atomicAdd(&(bar)[XB_TMO], 1u); break; } } } } while (0)

struct XcdBarrier {
    unsigned* bar; unsigned x;
    volatile LAS unsigned* st;
};

__device__ __forceinline__ XcdBarrier xcd_barrier_post(unsigned* bar, volatile LAS unsigned* st) {
    XcdBarrier b; b.bar = bar; b.x = xb_xcc_id(); b.st = st;
    if (threadIdx.x == 0) (void)xb_add(&bar[XB_XCNT(b.x)], 1u);
    return b;
}
__device__ __forceinline__ void xcd_barrier_complete(unsigned* bar, unsigned x, unsigned& nloc, unsigned& nx) {
    const unsigned G = gridDim.x * gridDim.y * gridDim.z;
    unsigned sum, cnt, mine, sp = 0u;
    for (;;) {
        sum = 0u; cnt = 0u; mine = 0u;
#pragma unroll
        for (unsigned j = 0; j < 16; ++j) { const unsigned c = xb_ld(&bar[XB_XCNT(j)]); sum += c; cnt += (c > 0u) ? 1u : 0u; mine = (j == x) ? c : mine; }
        if (sum == G) break;
        __builtin_amdgcn_s_sleep(1);
        if ((++sp & 255u) == 0u) { if (xb_ld(&bar[XB_TMO])) break; if (sp > XB_SPIN_CAP) { atomicAdd(&bar[XB_TMO], 1u); break; } }
    }
    nloc = mine > 0u ? mine : 1u; nx = cnt > 0u ? cnt : 1u;
}

__device__ __forceinline__ void xcd_barrier(const XcdBarrier& b) {
    asm volatile("s_waitcnt vmcnt(0)" ::: "memory");
    __syncthreads();
    if (threadIdx.x == 0) {
        unsigned* bar = b.bar;
        __builtin_amdgcn_s_waitcnt(0);
        unsigned nloc = b.st[0], nx = b.st[1];
        if (nloc == 0u) { xcd_barrier_complete(bar, b.x, nloc, nx); b.st[0] = nloc; b.st[1] = nx; }
        const unsigned old = xb_add(&bar[XB_XSUB(b.x)], 1u);
        const unsigned gen = old / nloc;
        if (old + 1u == (gen + 1u) * nloc) {
            __builtin_amdgcn_fence(__ATOMIC_RELEASE, "agent");
            asm volatile("s_waitcnt vmcnt(0)" ::: "memory");
            const unsigned og = xb_add(&bar[XB_TOP], 1u);
            const unsigned tg = og / nx;
            if (og + 1u == (tg + 1u) * nx) xb_add(&bar[XB_TOPGEN], 1u);
            else XB_SPIN(xb_ld(&bar[XB_TOPGEN]) == tg, bar);
            __builtin_amdgcn_fence(__ATOMIC_ACQUIRE, "agent");
            xb_add(&bar[XB_XGEN(b.x)], 1u);
            asm volatile("s_waitcnt vmcnt(0)" ::: "memory");
        } else {
            XB_SPIN(xb_ld(&bar[XB_XGEN(b.x)]) == gen, bar);
            __builtin_amdgcn_fence(__ATOMIC_ACQUIRE, "agent");
            asm volatile("s_waitcnt vmcnt(0)" ::: "memory");
        }
    }
    __syncthreads();
}

constexpr int DM = 2048, MP = 8192, MS = 32, MT = MP + MS;
constexpr int NAB = 6144, NC = 8192;
constexpr size_t al256(size_t x) { return (x + 255) & ~(size_t)255; }
constexpr size_t WS_XB = 0;
constexpr size_t WS_H = al256(WS_XB + (size_t)MT * DM * 2);
constexpr size_t WS_RSS = al256(WS_H + (size_t)MT * DM * 4);
constexpr size_t WS_PROJ = al256(WS_RSS + (size_t)5 * MT * 4);
constexpr size_t WS_ZCAT = al256(WS_PROJ + (size_t)MT * NC * 2);
constexpr size_t WS_OG = al256(WS_ZCAT + (size_t)MT * DM * 2);
constexpr size_t WS_LSE = al256(WS_OG + (size_t)3 * MP * DM * 2);
constexpr size_t WS_WINAB = al256(WS_LSE + (size_t)3 * MP * 16 * 4);
constexpr size_t WS_WOUTAB = al256(WS_WINAB + (size_t)2 * NAB * DM * 2);
constexpr size_t WS_WINC = al256(WS_WOUTAB + (size_t)2 * DM * DM * 2);
constexpr size_t WS_WOUTC = al256(WS_WINC + (size_t)2 * NC * DM * 2);
constexpr size_t WS_PLIN = al256(WS_WOUTC + (size_t)2 * DM * DM * 2);
constexpr size_t WS_QS = al256(WS_PLIN + (size_t)2 * 4 * 256 * 256 * 2);
constexpr size_t WS_BAR = al256(WS_QS + (size_t)32 * 2048 * 2);
constexpr size_t WS_END = al256(WS_BAR + (size_t)XCD_BAR_WORDS * 4);
constexpr size_t HM = (size_t)2 * 16 * 4096 * 128;
constexpr size_t WS_QH = WS_PROJ, WS_KH = WS_QH + HM * 2, WS_VH = WS_KH + HM * 2, WS_SG = WS_VH + HM * 2;
static_assert(WS_SG + (size_t)MT * DM * 2 <= WS_ZCAT, "C-layer buffers must fit the proj region");
constexpr size_t O_YP = 0, O_YS = O_YP + (size_t)MP * DM, O_PP = O_YS + (size_t)MS * DM, O_PS = O_PP + 2 * 2 * 15 * 1024, O_CP = O_PS + 2 * 8 * 15 * 1024,
                 O_CS = O_CP + 2 * 2 * 2 * 1024, O_KP = O_CS + 2 * 8 * 2 * 1024, O_KS = O_KP + (size_t)2 * 2 * 2048 * 2048, O_VP = O_KS + (size_t)2 * 8 * 2048 * 2048,
                 O_VS = O_VP + (size_t)2 * 2 * 2048 * 2048, O_END = O_VS + (size_t)2 * 8 * 2048 * 2048;
constexpr int LDS_BYTES = 163840;
constexpr int ST_OFF = LDS_BYTES - 16;
constexpr float QSCALE = 0.08838834764831845f * 1.4426950408889634f;

struct Params { const float* in[15]; float* out; unsigned char* ws; };
__device__ __forceinline__ int ltid() { int t = threadIdx.x; asm volatile("" : "+v"(t)); return t; }
__device__ __forceinline__ int lbid() { int t = blockIdx.x; asm volatile("" : "+s"(t)); return t; }
typedef const __attribute__((address_space(4))) Params* KP;
__device__ __forceinline__ KP getp() { KP pp = (KP)__builtin_amdgcn_kernarg_segment_ptr(); asm volatile("" : "+s"(pp)); return pp; }
enum { I_XP = 0, I_XS, I_SPOOL, I_SCONV, I_CK, I_CV, I_NW, I_FNW, I_WINAB, I_PLIN, I_PSCALE, I_CONVW, I_WOUTAB, I_WINC, I_WOUTC };

__device__ __forceinline__ float bf2f(bf16_t b) { return __uint_as_float(((unsigned)b) << 16); }
__device__ __forceinline__ float bflo(unsigned w) { return __uint_as_float(w << 16); }
__device__ __forceinline__ float bfhi(unsigned w) { return __uint_as_float(w & 0xffff0000u); }
__device__ __forceinline__ float silu_f(float x) { return x / (1.f + __expf(-x)); }
__device__ __forceinline__ float wave_sum(float v) {
#pragma unroll
    for (int o = 32; o >= 1; o >>= 1) v += __shfl_xor(v, o);
    return v; }
__device__ __forceinline__ float wave_max(float v) {
#pragma unroll
    for (int o = 32; o >= 1; o >>= 1) v = fmaxf(v, __shfl_xor(v, o));
    return v; }

constexpr int NABO = 4096;
struct QInABtag {}; struct QInAB {
    static constexpr bool NEED_SS = false, RES_EPI = false, INIT = false;
    const float* rss; bf16_t* proj; float* rss_next;
    __device__ __forceinline__ float rowscale(int row) const { return rsqrtf(rss[row] * (1.f / 2048.f) + 1e-6f); }
    __device__ __forceinline__ void pair(int row, int col, f32x4 v0, f32x4 v1, float rs, float& ss) const {
        v0 *= rs; v1 *= rs;
        bf16_t* dst = proj + (size_t)row * NABO;
        if (col < 2048) {
            if (col >= 1024) {
#pragma unroll
                for (int e = 0; e < 4; ++e) { v0[e] = silu_f(v0[e]); v1[e] = silu_f(v1[e]); }
            }
            u32x4 w; w.x = cvt_pk_bf16(v0[0], v0[1]); w.y = cvt_pk_bf16(v0[2], v0[3]); w.z = cvt_pk_bf16(v1[0], v1[1]); w.w = cvt_pk_bf16(v1[2], v1[3]);
            *(u32x4*)(dst + col) = w;
        } else {
            const int second = col >= 4096, ch = ((col - 2048) & 2047) >> 1;
            if (second) {
#pragma unroll
                for (int e = 0; e < 4; ++e) v1[e] = silu_f(v1[e]);
            }
            const f32x4 z = v0 * v1;
            u32x2 w; w.x = cvt_pk_bf16(z[0], z[1]); w.y = cvt_pk_bf16(z[2], z[3]); *(u32x2*)(dst + 2048 + second * 1024 + ch) = w;
        }
    }
    __device__ __forceinline__ void pair_main(int row, int col, f32x4 v0, f32x4 v1, float rs, float& ss) const { pair(row, col, v0, v1, rs, ss); }
};
struct QInC {
    static constexpr bool NEED_SS = false, RES_EPI = false, INIT = false;
    const float* rss; bf16_t* qh; bf16_t* qs; float* kp; float* ks; float* vp; float* vs; float* rss_next;
    __device__ __forceinline__ float rowscale(int row) const { return rsqrtf(rss[row] * (1.f / 2048.f) + 1e-6f); }
    __device__ __forceinline__ void pair(int row, int col, f32x4 v0, f32x4 v1, float rs, float& ss) const {
        v0 *= rs; v1 *= rs;
        const int seg = col >> 11, cc = col & 2047;
        if (seg == 1 || seg == 2) {
            float* dst;
            if (row < MP) { const int b = row >> 12, t = row & 4095; dst = (t >= 2048) ? ((seg == 1 ? kp : vp) + ((size_t)(b * 2048 + (t - 2048)) * 2048 + cc)) : nullptr; }
            else { const int r = row - MP, b = r >> 2, s = r & 3; dst = (seg == 1 ? ks : vs) + ((size_t)(b * 2048 + 2044 + s) * 2048 + cc); }
            if (dst) { __builtin_nontemporal_store(v0, (f32x4*)dst); __builtin_nontemporal_store(v1, (f32x4*)(dst + 4)); }
        }
        if (seg == 0) { v0 *= QSCALE; v1 *= QSCALE; }
        if (seg == 3) {
#pragma unroll
            for (int e = 0; e < 4; ++e) { v0[e] = silu_f(v0[e]); v1[e] = silu_f(v1[e]); }
        }
        u32x4 w; w.x = cvt_pk_bf16(v0[0], v0[1]); w.y = cvt_pk_bf16(v0[2], v0[3]); w.z = cvt_pk_bf16(v1[0], v1[1]); w.w = cvt_pk_bf16(v1[2], v1[3]);
        bf16_t* d2;
        if (seg == 3) d2 = qh + 3 * HM + (size_t)row * DM + cc;
        else if (row < MP) d2 = qh + (size_t)seg * HM + ((size_t)((row >> 12) * 16 + (cc >> 7)) * 4096 + (row & 4095)) * 128 + (cc & 127);
        else d2 = seg == 0 ? qs + (size_t)(row - MP) * DM + cc : nullptr;
        if (d2) *(u32x4*)d2 = w;
    }
    __device__ __forceinline__ void pair_main(int row, int col, f32x4 v0, f32x4 v1, float rs, float& ss) const { pair(row, col, v0, v1, rs, ss); }
};
template <int resb, int wh, int wx> struct QOut {
    static constexpr bool NEED_SS = true, RES_EPI = resb != 0, INIT = resb == 0;
    const float* hold_p; const float* hold_s; float* hbuf; bf16_t* xb; float* rss_next;
    __device__ __forceinline__ float rowscale(int) const { return 1.f; }
    __device__ __forceinline__ u32x4 res_raw(int row, int col) const { return *(const u32x4*)(xb + (size_t)row * DM + col); }
    __device__ __forceinline__ void pair_res(int row, int col, f32x4 v0, f32x4 v1, u32x4 w, float& ss) const {
        pair_main(row, col, v0 + (f32x4){bflo(w.x), bfhi(w.x), bflo(w.y), bfhi(w.y)}, v1 + (f32x4){bflo(w.z), bfhi(w.z), bflo(w.w), bfhi(w.w)}, 1.f, ss); }
    __device__ __forceinline__ void load_res8(int row, int col, f32x4& r0, f32x4& r1) const {
        if (resb) { const u32x4 w = *(const u32x4*)(xb + (size_t)row * DM + col); r0 = (f32x4){bflo(w.x), bfhi(w.x), bflo(w.y), bfhi(w.y)}; r1 = (f32x4){bflo(w.z), bfhi(w.z), bflo(w.w), bfhi(w.w)}; }
        else { const float* src = (row < MP ? hold_p + (size_t)row * DM : hold_s + (size_t)(row - MP) * DM) + col; r0 = *(const f32x4*)src; r1 = *(const f32x4*)(src + 4); }
    }
    __device__ __forceinline__ void pair_main(int row, int col, f32x4 o0, f32x4 o1, float rs, float& ss) const {
        if (wh) { float* hd = hbuf + (size_t)row * DM + col; *(f32x4*)hd = o0; *(f32x4*)(hd + 4) = o1; }
        if (wx) { u32x4 w; w.x = cvt_pk_bf16(o0[0], o0[1]); w.y = cvt_pk_bf16(o0[2], o0[3]); w.z = cvt_pk_bf16(o1[0], o1[1]); w.w = cvt_pk_bf16(o1[2], o1[3]);
                  *(u32x4*)(xb + (size_t)row * DM + col) = w; }
        ss += ((o0[0] * o0[0] + o0[1] * o0[1]) + (o0[2] * o0[2] + o0[3] * o0[3])) + ((o1[0] * o1[0] + o1[1] * o1[1]) + (o1[2] * o1[2] + o1[3] * o1[3]));
    }
    __device__ __forceinline__ void pair(int row, int col, f32x4 v0, f32x4 v1, float rs, float& ss) const { f32x4 r0, r1; load_res8(row, col, r0, r1); pair_main(row, col, r0 + v0, r1 + v1, rs, ss); }
};
constexpr int CP_PER_WG = 130816, CP_PER_EPI = 7680, CP_NJ = 15;
template <class Q> struct EpiMain {
    static constexpr bool PERM = true, AFTER_DRAIN = false, HAS_INIT = Q::INIT;
    Q q; const f32x4* csrc; f32x4* cdst; mutable int seq;
    __device__ __forceinline__ void init(f32x4 (&acc)[2][2][4][2], const pg8::Unit& u, int wr, int wc, int fr, int fq) const {
        if constexpr (HAS_INIT) {
            const int row0 = u.pm * 256 + wr * 64 + fr, col0 = u.pn * 256 + wc * 32 + 8 * fq;
#pragma unroll
            for (int ai = 0; ai < 2; ++ai)
#pragma unroll
                for (int m = 0; m < 4; ++m)
#pragma unroll
                    for (int bj = 0; bj < 2; ++bj) q.load_res8(row0 + ai * 128 + m * 16, col0 + bj * 128, acc[ai][bj][m][0], acc[ai][bj][m][1]);
        }
    }
    __device__ __forceinline__ void operator()(const f32x4 (&acc)[2][2][4][2], const pg8::Unit& u, int wr, int wc, int fr, int fq) const {
        const int row0 = u.pm * 256 + wr * 64 + fr, col0 = u.pn * 256 + wc * 32 + 8 * fq;
        float rsv[2][4];
#pragma unroll
        for (int ai = 0; ai < 2; ++ai)
#pragma unroll
            for (int m = 0; m < 4; ++m) rsv[ai][m] = q.rowscale(row0 + ai * 128 + m * 16);
        asm volatile("" : "+v"(rsv[0][0]), "+v"(rsv[0][1]), "+v"(rsv[0][2]), "+v"(rsv[0][3]), "+v"(rsv[1][0]), "+v"(rsv[1][1]), "+v"(rsv[1][2]), "+v"(rsv[1][3]) :: "memory");
        f32x4 cb[8]; const int cidx = seq * CP_PER_EPI + (wr * 4 + wc) * 64 + fq * 16 + fr;
#define CP_IX(j) ((cidx + (j) * 512) < CP_PER_WG ? (cidx + (j) * 512) : CP_PER_WG - 1)
        if (csrc) {
#pragma unroll
            for (int j = 0; j < 8; ++j) cb[j] = __builtin_nontemporal_load(csrc + CP_IX(j));
        }
#pragma unroll
        for (int ai = 0; ai < 2; ++ai) {
            u32x4 rr[4][2];
            if constexpr (Q::RES_EPI) {
#pragma unroll
                for (int m = 0; m < 4; ++m)
#pragma unroll
                    for (int bj = 0; bj < 2; ++bj) rr[m][bj] = q.res_raw(row0 + ai * 128 + m * 16, col0 + bj * 128);
            }
#pragma unroll
            for (int m = 0; m < 4; ++m) {
                const int row = row0 + ai * 128 + m * 16; const float rs = rsv[ai][m]; float ss = 0.f;
#pragma unroll
                for (int bj = 0; bj < 2; ++bj) {
                    if constexpr (Q::RES_EPI) q.pair_res(row, col0 + bj * 128, acc[ai][bj][m][0], acc[ai][bj][m][1], rr[m][bj], ss);
                    else q.pair_main(row, col0 + bj * 128, acc[ai][bj][m][0], acc[ai][bj][m][1], rs, ss);
                }
                if (Q::NEED_SS) { ss += __shfl_xor(ss, 16); ss += __shfl_xor(ss, 32); if (fq == 0) atomicAdd(q.rss_next + row, ss); }
                asm volatile("" ::: "memory");
            }
            if (csrc) {
                if (ai == 0) {
#pragma unroll
                    for (int j = 0; j < 8; ++j) __builtin_nontemporal_store(cb[j], cdst + CP_IX(j));
#pragma unroll
                    for (int j = 0; j < CP_NJ - 8; ++j) cb[j] = __builtin_nontemporal_load(csrc + CP_IX(8 + j));
                } else {
#pragma unroll
                    for (int j = 0; j < CP_NJ - 8; ++j) __builtin_nontemporal_store(cb[j], cdst + CP_IX(8 + j));
                }
            }
        }
#undef CP_IX
        ++seq;
    }
};
template <class Q> __device__ __forceinline__ void skinny_gemm(const bf16_t* A, const bf16_t* Bt, int N, const Q& q, LAS char* lds) {
    const int tid = ltid(), wid = tid >> 6, lane = tid & 63, fr = lane & 15, fq = lane >> 4;
    const int ntask = N / 32;
    LAS f32x4* part = (LAS f32x4*)lds;
    for (int task = blockIdx.x; task < ntask; task += gridDim.x) {
        const int n0 = task * 32, k0 = wid * 256;
        const bf16_t* a0 = A + (size_t)(MP + fr) * DM + k0 + fq * 8; const bf16_t* a1 = a0 + (size_t)16 * DM;
        const bf16_t* b0 = Bt + (size_t)(n0 + 8 * (fr >> 2) + (fr & 3)) * DM + k0 + fq * 8; const bf16_t* b1 = b0 + (size_t)4 * DM;
        f32x4 c00 = {0.f, 0.f, 0.f, 0.f}, c01 = c00, c10 = c00, c11 = c00;
#pragma unroll
        for (int hk = 0; hk < 2; ++hk) {
            bf16x8 bv0[4], bv1[4], x0[4], x1[4];
#pragma unroll
            for (int kk = 0; kk < 4; ++kk) { const int ko = (hk * 4 + kk) * 32; bv0[kk] = *(const bf16x8*)(b0 + ko); bv1[kk] = *(const bf16x8*)(b1 + ko); x0[kk] = *(const bf16x8*)(a0 + ko); x1[kk] = *(const bf16x8*)(a1 + ko); }
#pragma unroll
            for (int kk = 0; kk < 4; ++kk) {
                c00 = __builtin_amdgcn_mfma_f32_16x16x32_bf16(bv0[kk], x0[kk], c00, 0, 0, 0); c01 = __builtin_amdgcn_mfma_f32_16x16x32_bf16(bv1[kk], x0[kk], c01, 0, 0, 0);
                c10 = __builtin_amdgcn_mfma_f32_16x16x32_bf16(bv0[kk], x1[kk], c10, 0, 0, 0); c11 = __builtin_amdgcn_mfma_f32_16x16x32_bf16(bv1[kk], x1[kk], c11, 0, 0, 0);
            }
        }
        part[(wid * 4 + 0) * 64 + lane] = c00; part[(wid * 4 + 1) * 64 + lane] = c01; part[(wid * 4 + 2) * 64 + lane] = c10; part[(wid * 4 + 3) * 64 + lane] = c11;
        __syncthreads();
        if (wid < 2) {
            f32x4 v0 = part[(wid * 2) * 64 + lane], v1 = part[(wid * 2 + 1) * 64 + lane];
#pragma unroll
            for (int w = 1; w < 8; ++w) { v0 += part[(w * 4 + wid * 2) * 64 + lane]; v1 += part[(w * 4 + wid * 2 + 1) * 64 + lane]; }
            const int row = MP + wid * 16 + fr; const float rs = q.rowscale(row); float ss = 0.f;
            q.pair(row, n0 + 8 * fq, v0, v1, rs, ss);
            if (Q::NEED_SS) { ss += __shfl_xor(ss, 16); ss += __shfl_xor(ss, 32); if (fq == 0) atomicAdd(q.rss_next + row, ss); }
        }
        __syncthreads();
    }
}

__device__ __forceinline__ int ab_dst(int n) {
    if (n < 2048) return n;
    const int seg = n >> 10, ch = n & 1023;
    return ((seg == 3 || seg == 4) ? 2048 : 4096) + (ch >> 2) * 8 + ((seg >= 4) ? 4 : 0) + (ch & 3);
}
struct ConvTile { const float* W; bf16_t* Bt; const float* sc; int ldw, K, k0, n0; };
__device__ __forceinline__ ConvTile conv_decode(KP p, int tile) {
    unsigned char* ws = p->ws; ConvTile t; int r;
    if (tile < 4608) {
        const int i = tile / 2304; r = tile % 2304; t.K = 2048;
        if (r < 768) { t.W = p->in[I_WINAB] + (size_t)i * DM * NAB; t.ldw = NAB; t.Bt = (bf16_t*)(ws + WS_WINAB) + (size_t)i * NAB * DM; t.sc = p->in[I_NW] + (2 * i) * DM; }
        else if (r < 1024) { r -= 768; t.W = p->in[I_WOUTAB] + (size_t)i * DM * DM; t.ldw = DM; t.Bt = (bf16_t*)(ws + WS_WOUTAB) + (size_t)i * DM * DM; t.sc = nullptr; }
        else if (r < 2048) { r -= 1024; t.W = p->in[I_WINC] + (size_t)i * DM * NC; t.ldw = NC; t.Bt = (bf16_t*)(ws + WS_WINC) + (size_t)i * NC * DM; t.sc = p->in[I_NW] + (2 * i + 1) * DM; }
        else { r -= 2048; t.W = p->in[I_WOUTC] + (size_t)i * DM * DM; t.ldw = DM; t.Bt = (bf16_t*)(ws + WS_WOUTC) + (size_t)i * DM * DM; t.sc = nullptr; }
    } else { const int t2 = tile - 4608, mtx = t2 >> 2; r = t2 & 3; t.K = 256; t.ldw = 256; t.W = p->in[I_PLIN] + (size_t)mtx * 65536; t.Bt = (bf16_t*)(ws + WS_PLIN) + (size_t)mtx * 65536; t.sc = nullptr; }
    const int nN = t.ldw / 256; t.k0 = (r / nN) * 64; t.n0 = (r % nN) * 256;
    return t;
}
__device__ __forceinline__ void conv_load(const ConvTile& t, f32x4 (&v)[8], float (&sv)[8], int tid) {
#pragma unroll
    for (int p = 0; p < 8; ++p) {
        const int k = p * 8 + (tid >> 6), c4 = (tid & 63) * 4;
        v[p] = __builtin_nontemporal_load((const f32x4*)(t.W + (size_t)(t.k0 + k) * t.ldw + t.n0 + c4));
        sv[p] = t.sc ? t.sc[t.k0 + k] : 1.f;
    }
}
__device__ __forceinline__ void phase0(LAS char* lds) {
    KP p = getp();
    const int tid = ltid(), wid = tid >> 6, lane = tid & 63;
    unsigned char* ws = p->ws;
    {
        constexpr int PITCH = 258;
        LAS bf16_t* T = (LAS bf16_t*)lds;
        f32x4 v[8]; float sv[8];
        int tile = blockIdx.x;
        ConvTile cur = conv_decode(p, tile < 4640 ? tile : 0);
        if (tile < 4640) conv_load(cur, v, sv, tid);
        for (; tile < 4640; tile += gridDim.x) {
#pragma unroll
            for (int q = 0; q < 8; ++q) {
                const int k = q * 8 + (tid >> 6), c4 = (tid & 63) * 4;
                const f32x4 x = v[q] * sv[q];
                LAS unsigned* d = (LAS unsigned*)(T + k * PITCH + c4);
                d[0] = cvt_pk_bf16(x[0], x[1]); d[1] = cvt_pk_bf16(x[2], x[3]);
            }
            __syncthreads();
            const int nxt_tile = tile + gridDim.x;
            const ConvTile nxt = conv_decode(p, nxt_tile < 4640 ? nxt_tile : tile);
            if (nxt_tile < 4640) conv_load(nxt, v, sv, tid);
            const bool abmap = cur.ldw == NAB;
#pragma unroll
            for (int j = 0; j < 4; ++j) {
                const int ch = tid + j * 512, n = ch >> 3, kc = ch & 7;
                unsigned w[4];
#pragma unroll
                for (int e = 0; e < 4; ++e) { const unsigned lo = T[(kc * 8 + 2 * e) * PITCH + n], hi = T[(kc * 8 + 2 * e + 1) * PITCH + n]; w[e] = lo | (hi << 16); }
                u32x4 o = {w[0], w[1], w[2], w[3]};
                *(u32x4*)(cur.Bt + (size_t)(abmap ? ab_dst(cur.n0 + n) : cur.n0 + n) * cur.K + cur.k0 + kc * 8) = o;
            }
            __syncthreads();
            cur = nxt;
        }
    }
    float* rss = (float*)(ws + WS_RSS); bf16_t* xb = (bf16_t*)(ws + WS_XB);
    const int gw = blockIdx.x * 8 + wid, nw = gridDim.x * 8;
    for (int row = gw; row < MT; row += nw) {
        const float* src = row < MP ? p->in[I_XP] + (size_t)row * DM : p->in[I_XS] + (size_t)(row - MP) * DM;
        float ss = 0.f;
#pragma unroll
        for (int i = 0; i < 8; ++i) {
            const f32x4 v = *(const f32x4*)(src + (i * 64 + lane) * 4);
            ss += (v[0] * v[0] + v[1] * v[1]) + (v[2] * v[2] + v[3] * v[3]);
            u32x2 w; w.x = cvt_pk_bf16(v[0], v[1]); w.y = cvt_pk_bf16(v[2], v[3]);
            *(u32x2*)(xb + (size_t)row * DM + (i * 64 + lane) * 4) = w;
        }
        ss = wave_sum(ss);
        if (lane == 0) rss[row] = ss;
    }
    const int gtid = blockIdx.x * 512 + tid, nth = gridDim.x * 512;
    for (int i = gtid; i < 4 * MT; i += nth) rss[MT + i] = 0.f;
    if (gridDim.x != 256) {
        constexpr int CH4 = 2044 * 2048 / 4;
        for (int c = 0; c < 32; ++c) { const int kv = c >> 4, ib = c & 15;
            const f32x4* src = (const f32x4*)(p->in[kv ? I_CV : I_CK] + ((size_t)ib * 2048 + 4) * 2048);
            f32x4* dst = (f32x4*)(p->out + (kv ? O_VS : O_KS) + (size_t)ib * 2048 * 2048);
            for (int k = gtid; k < CH4; k += nth) __builtin_nontemporal_store(__builtin_nontemporal_load(src + k), dst + k); }
    }
}

__device__ __forceinline__ void mixer_phase(int i, LAS char* lds) {
    KP p = getp();
    const int tid = ltid(), wid = tid >> 6, lane = tid & 63, fr = lane & 15, fq = lane >> 4;
    unsigned char* ws = p->ws;
    const bf16_t* proj = (const bf16_t*)(ws + WS_PROJ); bf16_t* zcat = (bf16_t*)(ws + WS_ZCAT);
    const bf16_t* plinT = (const bf16_t*)(ws + WS_PLIN) + (size_t)i * 4 * 65536;
    const float* pscale = p->in[I_PSCALE] + i * 1024; const float* convw = p->in[I_CONVW] + i * 3 * 1024;
    constexpr int APITCH = 528;
    constexpr int UROWS = 143, AOFF = 75520;
    for (int task = blockIdx.x; task < 256; task += gridDim.x) {
        const int rt = task >> 2, g = task & 3, b = rt >> 5, t0 = (rt & 31) * 128, kwin = 2 << g;
        const size_t rbase = (size_t)b * 4096;
        const int chunk = tid & 31, rowgrp = tid >> 5;
        {
            const bf16_t* ub = proj + g * 256 + chunk * 8;
#pragma unroll
            for (int j = 0; j < 9; ++j) {
                const int lr = rowgrp + 16 * j;
                if (lr < UROWS) {
                    const int t = t0 - 15 + lr;
                    u32x4 v = {0u, 0u, 0u, 0u};
                    if (t >= 0) v = *(const u32x4*)(ub + (rbase + t) * NABO);
                    *(LAS u32x4*)(lds + lr * APITCH + chunk * 16) = v;
                }
            }
        }
        {
            const int c = g * 256 + chunk * 8;
            f32x4 w0a = *(const f32x4*)(convw + c), w0b = *(const f32x4*)(convw + c + 4), w1a = *(const f32x4*)(convw + 1024 + c), w1b = *(const f32x4*)(convw + 1024 + c + 4),
                  w2a = *(const f32x4*)(convw + 2048 + c), w2b = *(const f32x4*)(convw + 2048 + c + 4);
            const float w0[8] = {w0a[0], w0a[1], w0a[2], w0a[3], w0b[0], w0b[1], w0b[2], w0b[3]};
            const float w1[8] = {w1a[0], w1a[1], w1a[2], w1a[3], w1b[0], w1b[1], w1b[2], w1b[3]};
            const float w2[8] = {w2a[0], w2a[1], w2a[2], w2a[3], w2b[0], w2b[1], w2b[2], w2b[3]};
            float* cpo = p->out + O_CP + ((size_t)(i * 2 + b) * 2) * 1024 + c;
#pragma unroll 4
            for (int j = 0; j < 8; ++j) {
                const int t = t0 + rowgrp + 16 * j; const size_t ro = (rbase + t) * NABO + c;
                const u32x4 z4 = {0u, 0u, 0u, 0u};
                const u32x4 z0 = *(const u32x4*)(proj + ro + 2048);
                const u32x4 z1 = t >= 1 ? *(const u32x4*)(proj + ro - NABO + 2048) : z4;
                const u32x4 z2 = t >= 2 ? *(const u32x4*)(proj + ro - 2 * NABO + 2048) : z4;
                const u32x4 bg = *(const u32x4*)(proj + ro + 3072);
                u32x4 ov;
#pragma unroll
                for (int e = 0; e < 4; ++e) {
                    const float ya = bflo(z2[e]) * w0[2 * e] + bflo(z1[e]) * w1[2 * e] + bflo(z0[e]) * w2[2 * e];
                    const float yb = bfhi(z2[e]) * w0[2 * e + 1] + bfhi(z1[e]) * w1[2 * e + 1] + bfhi(z0[e]) * w2[2 * e + 1];
                    ov[e] = cvt_pk_bf16(bflo(bg[e]) * ya, bfhi(bg[e]) * yb);
                }
                *(u32x4*)(zcat + (rbase + t) * DM + 1024 + c) = ov;
                if (t >= 4094) { float* d = cpo + (size_t)(t - 4094) * 1024; *(f32x4*)d = (f32x4){bflo(z0[0]), bfhi(z0[0]), bflo(z0[1]), bfhi(z0[1])}; *(f32x4*)(d + 4) = (f32x4){bflo(z0[2]), bfhi(z0[2]), bflo(z0[3]), bfhi(z0[3])}; }
            }
        }
        __syncthreads();
        {
            float* pp = p->out + O_PP + ((size_t)(i * 2 + b) * 15) * 1024 + g * 256 + chunk * 8;
#pragma unroll 2
            for (int j = 0; j < 8; ++j) {
                const int lr = rowgrp + 16 * j, t = t0 + lr;
                float sacc[8];
#pragma unroll
                for (int e = 0; e < 8; ++e) sacc[e] = 0.f;
                u32x4 cur = {0u, 0u, 0u, 0u};
                for (int j2 = 0; j2 < kwin; ++j2) {
                    const u32x4 v = *(LAS const u32x4*)(lds + (lr + 15 - j2) * APITCH + chunk * 16);
                    if (j2 == 0) cur = v;
#pragma unroll
                    for (int e = 0; e < 4; ++e) { sacc[2 * e] += bflo(v[e]); sacc[2 * e + 1] += bfhi(v[e]); }
                }
                const float inv = 1.f / fminf((float)kwin, (float)(t + 1));
                u32x4 ov;
#pragma unroll
                for (int e = 0; e < 4; ++e) ov[e] = cvt_pk_bf16(sacc[2 * e] * inv - bflo(cur[e]), sacc[2 * e + 1] * inv - bfhi(cur[e]));
                *(LAS u32x4*)(lds + AOFF + lr * APITCH + chunk * 16) = ov;
                if (t >= 4081) { float* d = pp + (size_t)(t - 4081) * 1024;
                    *(f32x4*)d = (f32x4){bflo(cur[0]), bfhi(cur[0]), bflo(cur[1]), bfhi(cur[1])}; *(f32x4*)(d + 4) = (f32x4){bflo(cur[2]), bfhi(cur[2]), bflo(cur[3]), bfhi(cur[3])}; }
            }
        }
        __syncthreads();
        {
            const int wr = wid >> 2, wc = wid & 3;
            f32x4 acc[4][4];
#pragma unroll
            for (int m = 0; m < 4; ++m)
#pragma unroll
                for (int n = 0; n < 4; ++n) acc[m][n] = (f32x4){0.f, 0.f, 0.f, 0.f};
            const bf16_t* Bg = plinT + (size_t)g * 65536 + (size_t)(wc * 64 + fr) * 256 + fq * 8;
            LAS const char* Al = lds + AOFF + (wr * 64 + fr) * APITCH + fq * 16;
#pragma unroll 2
            for (int ks = 0; ks < 8; ++ks) {
                bf16x8 a[4], bb[4];
#pragma unroll
                for (int m = 0; m < 4; ++m) a[m] = *(LAS const bf16x8*)(Al + m * 16 * APITCH + ks * 64);
#pragma unroll
                for (int n = 0; n < 4; ++n) bb[n] = *(const bf16x8*)(Bg + (size_t)n * 16 * 256 + ks * 32);
#pragma unroll
                for (int m = 0; m < 4; ++m)
#pragma unroll
                    for (int n = 0; n < 4; ++n) acc[m][n] = __builtin_amdgcn_mfma_f32_16x16x32_bf16(bb[n], a[m], acc[m][n], 0, 0, 0);
            }
#pragma unroll
            for (int m = 0; m < 4; ++m) {
                const size_t row = rbase + t0 + wr * 64 + m * 16 + fr;
#pragma unroll
                for (int n = 0; n < 4; ++n) {
                    const int ch = g * 256 + wc * 64 + n * 16 + fq * 4;
                    const f32x4 sc = *(const f32x4*)(pscale + ch);
                    const u32x2 sg = *(const u32x2*)(proj + row * NABO + 1024 + ch);
                    const f32x4 v = acc[m][n] * sc;
                    u32x2 w; w.x = cvt_pk_bf16(v[0] * bflo(sg.x), v[1] * bfhi(sg.x)); w.y = cvt_pk_bf16(v[2] * bflo(sg.y), v[3] * bfhi(sg.y));
                    *(u32x2*)(zcat + row * DM + ch) = w;
                }
            }
        }
        __syncthreads();
    }
    for (int st = blockIdx.x; st < 256; st += gridDim.x) {
        const int b = st >> 5, g = (st >> 3) & 3, dq = st & 7, kwin = 2 << g;
        LAS float* PS = (LAS float*)lds;
        LAS float* RS = PS + 1024;
        if (tid < 256) {
            const int c = g * 256 + tid;
            float ua[19];
            const float* sp = p->in[I_SPOOL] + ((size_t)(i * 8 + b) * 15) * 1024 + c;
#pragma unroll
            for (int j = 0; j < 15; ++j) ua[j] = sp[(size_t)j * 1024];
#pragma unroll
            for (int s = 0; s < 4; ++s) ua[15 + s] = bf2f(proj[(size_t)(MP + b * 4 + s) * NABO + c]);
            const float inv = 1.f / (float)kwin;
#pragma unroll
            for (int s = 0; s < 4; ++s) {
                float a = 0.f;
#pragma unroll
                for (int j = 0; j < 16; ++j) a += (j < kwin) ? ua[15 + s - j] : 0.f;
                PS[s * 256 + tid] = a * inv - ua[15 + s];
            }
            if (dq == 0) {
                float* po = p->out + O_PS + ((size_t)(i * 8 + b) * 15) * 1024 + c;
#pragma unroll
                for (int j = 0; j < 15; ++j) po[(size_t)j * 1024] = ua[4 + j];
            }
        } else if (dq == 0) {
            const int c = g * 256 + (tid - 256);
            const float* scv = p->in[I_SCONV] + ((size_t)(i * 8 + b) * 2) * 1024 + c;
            float za[6]; za[0] = scv[0]; za[1] = scv[1024];
#pragma unroll
            for (int s = 0; s < 4; ++s) za[2 + s] = bf2f(proj[(size_t)(MP + b * 4 + s) * NABO + 2048 + c]);
            const float w0 = convw[c], w1 = convw[1024 + c], w2 = convw[2048 + c];
#pragma unroll
            for (int s = 0; s < 4; ++s) {
                const size_t ro = (size_t)(MP + b * 4 + s) * NABO;
                const float y = za[s] * w0 + za[s + 1] * w1 + za[s + 2] * w2;
                zcat[(size_t)(MP + b * 4 + s) * DM + 1024 + c] = (bf16_t)(cvt_pk_bf16(bf2f(proj[ro + 3072 + c]) * y, 0.f) & 0xffffu);
            }
            float* co = p->out + O_CS + ((size_t)(i * 8 + b) * 2) * 1024 + c;
            co[0] = za[4]; co[1024] = za[5];
        }
        __syncthreads();
        {
            const int dl = tid & 31, s = (tid >> 5) & 3, cs = tid >> 7;
            const float* P = p->in[I_PLIN] + ((size_t)(i * 4 + g) * 256 + cs * 64) * 256 + dq * 32 + dl;
            LAS const float* ps = PS + s * 256 + cs * 64;
            float a = 0.f;
#pragma unroll 16
            for (int c2 = 0; c2 < 64; ++c2) a += ps[c2] * P[(size_t)c2 * 256];
            RS[(cs * 4 + s) * 32 + dl] = a;
        }
        __syncthreads();
        if (tid < 128) {
            const int dl = tid & 31, s = tid >> 5, ch = g * 256 + dq * 32 + dl;
            const float a = (RS[s * 32 + dl] + RS[(4 + s) * 32 + dl]) + (RS[(8 + s) * 32 + dl] + RS[(12 + s) * 32 + dl]);
            const size_t row = (size_t)(MP + b * 4 + s);
            zcat[row * DM + ch] = (bf16_t)(cvt_pk_bf16(a * pscale[ch] * bf2f(proj[row * NABO + 1024 + ch]), 0.f) & 0xffffu);
        }
        __syncthreads();
    }
}

__device__ __forceinline__ int crow(int r, int hi) { return (r & 3) + 8 * (r >> 2) + 4 * hi; }
__device__ __forceinline__ s16x4 vtr(LAS const char* ptr) { return __builtin_bit_cast(s16x4, __builtin_amdgcn_ds_read_tr16_b64_v4i16((LAS v4i16_t*)ptr)); }
#define VM_WAIT(n) asm volatile("s_waitcnt vmcnt(" #n ")" ::: "memory")
#define TR8(base, off, a0, a1, a2, a3, a4, a5, a6, a7) asm volatile( \
    "ds_read_b64_tr_b16 %0, %8 offset:%9\n\tds_read_b64_tr_b16 %1, %8 offset:%9+512\n\tds_read_b64_tr_b16 %2, %8 offset:%9+1024\n\tds_read_b64_tr_b16 %3, %8 offset:%9+1536\n\t" \
    "ds_read_b64_tr_b16 %4, %8 offset:%9+2048\n\tds_read_b64_tr_b16 %5, %8 offset:%9+2560\n\tds_read_b64_tr_b16 %6, %8 offset:%9+3072\n\tds_read_b64_tr_b16 %7, %8 offset:%9+3584\n\t" \
    "s_waitcnt lgkmcnt(0)" \
    : "=&v"(a0), "=&v"(a1), "=&v"(a2), "=&v"(a3), "=&v"(a4), "=&v"(a5), "=&v"(a6), "=&v"(a7) : "v"(base), "i"(off) : "memory")
__device__ __forceinline__ void attn_issue_k(bf16x8 (&kf)[8], const bf16_t* kb, size_t rowb, int mk0, int dil, int lane) {
    const int r32 = lane & 31, hi = lane >> 5;
    const bf16_t* kp = kb + (rowb + (size_t)(mk0 + r32) * dil) * 128 + hi * 8;
#pragma unroll
    for (int d0 = 0; d0 < 8; ++d0) kf[d0] = *(const bf16x8*)(kp + d0 * 16);
}
__device__ __forceinline__ void attn_issue_v(const bf16_t* vb, size_t rowb, int mk0, int dil, LAS char* vbuf, int lane) {
    const bf16_t* vp0 = vb + (rowb + (size_t)(mk0 + (lane >> 2)) * dil) * 128 + (lane & 3) * 8;
    const bf16_t* vp1 = vp0 + (size_t)16 * dil * 128;
#pragma unroll
    for (int ii = 0; ii < 8; ++ii)
        __builtin_amdgcn_global_load_lds((const unsigned*)(((ii & 1) ? vp1 : vp0) + (ii >> 1) * 32), (LAS unsigned*)(vbuf + ii * 1024), 16, 0, 0);
}
__device__ __forceinline__ void attn_wave_task(const bf16_t* qkvg, int b, int h, int dil, int r, int m0, bf16_t* og, float* lse, LAS char* vl, int lane) {
    const int r32 = lane & 31, hi = lane >> 5;
    const size_t hb = (size_t)(b * 16 + h) * 4096 * 128;
    const bf16_t* qb = qkvg + hb, * kb = qkvg + HM + hb, * vb = qkvg + 2 * HM + hb;
    const size_t rowb = (size_t)r;
    const size_t qrow = rowb + (size_t)(m0 + r32) * dil;
    int kt = m0 >= 128 ? 0 : (128 - m0) / 32;
    int par = 0;
    bf16x8 kf[8];
    attn_issue_v(vb, rowb, m0 - 128 + 32 * kt, dil, vl, lane);
    attn_issue_k(kf, kb, rowb, m0 - 128 + 32 * kt, dil, lane);
    bf16x8 qf[8];
#pragma unroll
    for (int d0 = 0; d0 < 8; ++d0) qf[d0] = *(const bf16x8*)(qb + qrow * 128 + d0 * 16 + hi * 8);
    f32x16 o[4];
#pragma unroll
    for (int dt = 0; dt < 4; ++dt)
#pragma unroll
        for (int e = 0; e < 16; ++e) o[dt][e] = 0.f;
    float m_run = -1e30f, l_run = 0.f;
    const int i16 = lane & 15, tq = i16 >> 2, tp = i16 & 3, dblk = (lane >> 4) & 1;
    const unsigned tr0 = (unsigned)(size_t)vl + (4 * hi + tq) * 64 + dblk * 32 + 8 * tp;
    for (;;) {
        const bool hn = kt + 1 < 5;
        f32x16 pt;
#pragma unroll
        for (int e = 0; e < 16; ++e) pt[e] = 0.f;
#pragma unroll
        for (int d0 = 0; d0 < 8; ++d0) pt = __builtin_amdgcn_mfma_f32_32x32x16_bf16(kf[d0], qf[d0], pt, 0, 0, 0);
        asm volatile("" : "+v"(pt) :: "memory");
        if (hn) {
            attn_issue_v(vb, rowb, m0 - 128 + 32 * (kt + 1), dil, vl + (par ^ 1) * 8192, lane);
            attn_issue_k(kf, kb, rowb, m0 - 128 + 32 * (kt + 1), dil, lane);
        }
        asm volatile("" ::: "memory");
        const float NEG = -__builtin_inff();
        if (kt == 0) {
#pragma unroll
            for (int e = 0; e < 16; ++e) if (crow(e, hi) < r32) pt[e] = NEG;
        }
        if (kt == 4) {
#pragma unroll
            for (int e = 0; e < 16; ++e) if (crow(e, hi) > r32) pt[e] = NEG;
        }
        float tmax = pt[0];
#pragma unroll
        for (int e = 1; e < 16; ++e) tmax = fmaxf(tmax, pt[e]);
        { auto rr = __builtin_amdgcn_permlane32_swap(__float_as_uint(tmax), __float_as_uint(tmax), false, false); tmax = fmaxf(__uint_as_float(rr[0]), __uint_as_float(rr[1])); }
        const float mn = fmaxf(m_run, tmax), alpha = __builtin_amdgcn_exp2f(m_run - mn); m_run = mn;
        float ps = 0.f;
#pragma unroll
        for (int e = 0; e < 16; ++e) { pt[e] = __builtin_amdgcn_exp2f(pt[e] - mn); ps += pt[e]; }
        { auto rr = __builtin_amdgcn_permlane32_swap(__float_as_uint(ps), __float_as_uint(ps), false, false); ps = __uint_as_float(rr[0]) + __uint_as_float(rr[1]); }
        l_run = l_run * alpha + ps;
        if (__any(alpha != 1.f)) {
#pragma unroll
            for (int dt = 0; dt < 4; ++dt)
#pragma unroll
                for (int e = 0; e < 16; ++e) o[dt][e] *= alpha;
        }
        bf16x8 pb[2];
#pragma unroll
        for (int s = 0; s < 2; ++s) {
            u32x4 w; w.x = cvt_pk_bf16(pt[8 * s + 0], pt[8 * s + 1]); w.y = cvt_pk_bf16(pt[8 * s + 2], pt[8 * s + 3]); w.z = cvt_pk_bf16(pt[8 * s + 4], pt[8 * s + 5]); w.w = cvt_pk_bf16(pt[8 * s + 6], pt[8 * s + 7]);
            pb[s] = __builtin_bit_cast(bf16x8, w);
        }
        if (hn) VM_WAIT(16); else VM_WAIT(0);
        const unsigned trb = tr0 + par * 8192;
#pragma unroll
        for (int dp = 0; dp < 2; ++dp) {
            s16x4 a0, a1, a2, a3, a4, a5, a6, a7;
            if (dp == 0) TR8(trb, 0, a0, a1, a2, a3, a4, a5, a6, a7); else TR8(trb, 4096, a0, a1, a2, a3, a4, a5, a6, a7);
            o[2 * dp] = __builtin_amdgcn_mfma_f32_32x32x16_bf16(__builtin_shufflevector(a0, a1, 0, 1, 2, 3, 4, 5, 6, 7), pb[0], o[2 * dp], 0, 0, 0);
            o[2 * dp] = __builtin_amdgcn_mfma_f32_32x32x16_bf16(__builtin_shufflevector(a2, a3, 0, 1, 2, 3, 4, 5, 6, 7), pb[1], o[2 * dp], 0, 0, 0);
            o[2 * dp + 1] = __builtin_amdgcn_mfma_f32_32x32x16_bf16(__builtin_shufflevector(a4, a5, 0, 1, 2, 3, 4, 5, 6, 7), pb[0], o[2 * dp + 1], 0, 0, 0);
            o[2 * dp + 1] = __builtin_amdgcn_mfma_f32_32x32x16_bf16(__builtin_shufflevector(a6, a7, 0, 1, 2, 3, 4, 5, 6, 7), pb[1], o[2 * dp + 1], 0, 0, 0);
        }
        if (!hn) break;
        ++kt; par ^= 1;
    }
    const float inv = 1.f / l_run;
    asm volatile("s_waitcnt vmcnt(0)" ::: "memory");
#pragma unroll
    for (int dt = 0; dt < 4; ++dt)
#pragma unroll
        for (int g4 = 0; g4 < 4; ++g4) {
            u32x2 w; w.x = cvt_pk_bf16(o[dt][4 * g4] * inv, o[dt][4 * g4 + 1] * inv); w.y = cvt_pk_bf16(o[dt][4 * g4 + 2] * inv, o[dt][4 * g4 + 3] * inv);
            *(LAS u32x2*)(vl + r32 * 272 + (dt * 32 + 8 * g4 + 4 * hi) * 2) = w;
        }
    __builtin_amdgcn_fence(__ATOMIC_RELEASE, "wavefront"); __builtin_amdgcn_wave_barrier();
#pragma unroll
    for (int k = 0; k < 8; ++k) {
        const int c = k * 64 + lane, rw = c >> 4, c16 = c & 15;
        const u32x4 w = *(LAS const u32x4*)(vl + rw * 272 + c16 * 16);
        *(u32x4*)(og + hb + (rowb + (size_t)(m0 + rw) * dil) * 128 + c16 * 8) = w;
    }
    __builtin_amdgcn_wave_barrier();
    if (hi == 0) lse[((size_t)(b * 16 + h) * 4096) + qrow] = m_run + __builtin_amdgcn_logf(l_run);
}
__device__ __forceinline__ void attn_sample_wave(KP p, int i, int b, int s, int h, int g, LAS float* part, int lane) {
    const bf16_t* qs = (const bf16_t*)(p->ws + WS_QS);
    const int kq = lane >> 4, dc = lane & 15, dil = 1 << (2 * g);
    LAS float* sc = part + 136;
    float q8[8];
    { const bf16x8 qv = *(const bf16x8*)(qs + (size_t)(b * 4 + s) * DM + h * 128 + dc * 8);
#pragma unroll
      for (int e = 0; e < 8; ++e) q8[e] = bf2f((bf16_t)qv[e]); }
    const size_t cbase = ((size_t)(i * 8 + b) * 2048) * 2048 + h * 128 + dc * 8;
    const float* ck = p->in[I_CK] + cbase; const float* cv = p->in[I_CV] + cbase;
    const float* kn = p->out + O_KS + cbase + (size_t)2044 * 2048;
    const float* vn = p->out + O_VS + cbase + (size_t)2044 * 2048;
#pragma unroll 1
    for (int bt = 0; bt < 3; ++bt) {
        f32x4 ka[11], kb2[11];
#pragma unroll
        for (int u = 0; u < 11; ++u) {
            const int j = (bt * 11 + u) * 4 + kq, jc = j > 128 ? 128 : j, idx = 2048 + s - dil * jc;
            const float* kr = idx >= 2048 ? kn + (size_t)(idx - 2048) * 2048 : ck + (size_t)idx * 2048;
            ka[u] = *(const f32x4*)kr; kb2[u] = *(const f32x4*)(kr + 4);
        }
#pragma unroll
        for (int u = 0; u < 11; ++u) {
            const int j = (bt * 11 + u) * 4 + kq;
            float d = (ka[u][0] * q8[0] + ka[u][1] * q8[1]) + (ka[u][2] * q8[2] + ka[u][3] * q8[3]) + (kb2[u][0] * q8[4] + kb2[u][1] * q8[5]) + (kb2[u][2] * q8[6] + kb2[u][3] * q8[7]);
            d += __shfl_xor(d, 1); d += __shfl_xor(d, 2); d += __shfl_xor(d, 4); d += __shfl_xor(d, 8);
            if (dc == 0) sc[j] = j <= 128 ? d : -1e30f;
        }
    }
    __builtin_amdgcn_fence(__ATOMIC_RELEASE, "wavefront"); __builtin_amdgcn_wave_barrier();
    float s0 = sc[lane], s1 = sc[lane + 64], s2 = lane < 4 ? sc[lane + 128] : -1e30f;
    const float mx = wave_max(fmaxf(s0, fmaxf(s1, s2)));
    s0 = __builtin_amdgcn_exp2f(s0 - mx); s1 = __builtin_amdgcn_exp2f(s1 - mx); s2 = __builtin_amdgcn_exp2f(s2 - mx);
    const float sum = wave_sum(s0 + s1 + s2);
    sc[lane] = s0; sc[lane + 64] = s1; if (lane < 4) sc[lane + 128] = s2;
    __builtin_amdgcn_fence(__ATOMIC_RELEASE, "wavefront"); __builtin_amdgcn_wave_barrier();
    float o8[8];
#pragma unroll
    for (int e = 0; e < 8; ++e) o8[e] = 0.f;
#pragma unroll 1
    for (int bt = 0; bt < 3; ++bt) {
        f32x4 va[11], vb2[11];
#pragma unroll
        for (int u = 0; u < 11; ++u) {
            const int j = (bt * 11 + u) * 4 + kq, jc = j > 128 ? 128 : j, idx = 2048 + s - dil * jc;
            const float* vr = idx >= 2048 ? vn + (size_t)(idx - 2048) * 2048 : cv + (size_t)idx * 2048;
            va[u] = *(const f32x4*)vr; vb2[u] = *(const f32x4*)(vr + 4);
        }
#pragma unroll
        for (int u = 0; u < 11; ++u) {
            const float pj = sc[(bt * 11 + u) * 4 + kq];
#pragma unroll
            for (int e = 0; e < 4; ++e) { o8[e] += pj * va[u][e]; o8[4 + e] += pj * vb2[u][e]; }
        }
    }
#pragma unroll
    for (int e = 0; e < 8; ++e) { o8[e] += __shfl_xor(o8[e], 16); o8[e] += __shfl_xor(o8[e], 32); }
    if (kq == 0) {
#pragma unroll
        for (int e = 0; e < 8; ++e) part[2 + dc * 8 + e] = o8[e];
    }
    if (lane == 0) { part[0] = mx; part[1] = sum; }
}
__device__ __forceinline__ void attn_phase(int i, LAS char* lds) {
    KP p = getp();
    const int tid = ltid(), wid = __builtin_amdgcn_readfirstlane(tid >> 6), lane = tid & 63;
    const bf16_t* qkvg = (const bf16_t*)(p->ws + WS_PROJ); bf16_t* zcat = (bf16_t*)(p->ws + WS_ZCAT); const bf16_t* sgb = (const bf16_t*)(p->ws + WS_SG);
    bf16_t* og = (bf16_t*)(p->ws + WS_OG); float* lse = (float*)(p->ws + WS_LSE);
    for (int base = blockIdx.x * 2; base < 512; base += gridDim.x * 2) {
        LAS float* parts = (LAS float*)lds;
#ifndef NO_SAMPLE
        if (wid < 6) { const int id = base + wid / 3; attn_sample_wave(p, i, id >> 6, (id >> 4) & 3, id & 15, wid % 3, parts + wid * 272, lane); }
#endif
        __syncthreads();
        if (tid < 256) {
            const int pr = tid >> 7, d = tid & 127, id = base + pr, row = MP + (id >> 6) * 4 + ((id >> 4) & 3), h = id & 15;
            LAS const float* P0 = parts + (pr * 3) * 272, * P1 = P0 + 272, * P2 = P1 + 272;
            const float mx = fmaxf(P0[0], fmaxf(P1[0], P2[0]));
            const float w0 = __builtin_amdgcn_exp2f(P0[0] - mx), w1 = __builtin_amdgcn_exp2f(P1[0] - mx), w2 = __builtin_amdgcn_exp2f(P2[0] - mx);
            const float L = w0 * P0[1] + w1 * P1[1] + w2 * P2[1];
            const float o = (w0 * P0[2 + d] + w1 * P1[2 + d] + w2 * P2[2 + d]) / L;
            const float sg = bf2f(sgb[(size_t)row * DM + h * 128 + d]);
            zcat[(size_t)row * DM + h * 128 + d] = (bf16_t)(cvt_pk_bf16(o * sg, 0.f) & 0xffffu);
        }
        __syncthreads();
    }
    LAS char* wl = lds + wid * 16384;
    {
        const int G = gridDim.x; int xcd, lw, nlw, per;
        if ((G & 7) == 0) { xcd = blockIdx.x & 7; lw = (blockIdx.x >> 3) * 8 + wid; nlw = G; per = 1536; }
        else { xcd = 0; lw = blockIdx.x * 8 + wid; nlw = G * 8; per = 12288; }
#ifdef PROBE_WT2
        for (int rep = 0; rep < 2; ++rep)
#endif
        for (int tau = lw; tau < per; tau += nlw) {
            const int bhi = tau / 384, within = tau - bhi * 384, win = within / 48, tk = within - win * 48;
            const int bh = (per == 1536) ? xcd + 8 * bhi : bhi, b = bh >> 4, h = bh & 15, T0 = win * 512;
            const int g = tk >> 4, sub = tk & 15;
            int dil, r, m0;
            if (g == 0) { dil = 1; r = 0; m0 = T0 + 32 * sub; }
            else if (g == 1) { dil = 4; r = sub & 3; m0 = (T0 >> 2) + 32 * (sub >> 2); }
            else { dil = 16; r = sub; m0 = T0 >> 4; }
#ifndef NO_MAIN
            attn_wave_task(qkvg, b, h, dil, r, m0, og + (size_t)g * HM, lse + (size_t)g * MP * 16, wl, lane);
#endif
        }
    }
}
__device__ __forceinline__ void attn_merge_phase() {
    KP p = getp();
    const int tid = ltid();
    bf16_t* zcat = (bf16_t*)(p->ws + WS_ZCAT); const bf16_t* sgb = (const bf16_t*)(p->ws + WS_SG);
    const bf16_t* og = (const bf16_t*)(p->ws + WS_OG); const float* lse = (const float*)(p->ws + WS_LSE);
    const int nth = gridDim.x * 512;
#pragma unroll 2
    for (int idx = blockIdx.x * 512 + tid; idx < MP * 256; idx += nth) {
        const int row = idx >> 8, chunk = idx & 255, h = chunk >> 4, b = row >> 12, t = row & 4095;
        const size_t li = (size_t)(b * 16 + h) * 4096 + t, oi = li * 128 + (chunk & 15) * 8;
        const float l0 = lse[li], l1 = lse[(size_t)MP * 16 + li], l2 = lse[(size_t)2 * MP * 16 + li];
        const float mx = fmaxf(l0, fmaxf(l1, l2));
        float w0 = __builtin_amdgcn_exp2f(l0 - mx), w1 = __builtin_amdgcn_exp2f(l1 - mx), w2 = __builtin_amdgcn_exp2f(l2 - mx);
        const float inv = 1.f / (w0 + w1 + w2); w0 *= inv; w1 *= inv; w2 *= inv;
        const u32x4 a0 = *(const u32x4*)(og + oi), a1 = *(const u32x4*)(og + HM + oi), a2 = *(const u32x4*)(og + 2 * HM + oi);
        const u32x4 sg = *(const u32x4*)(sgb + (size_t)row * DM + chunk * 8);
        u32x4 ov;
#pragma unroll
        for (int e = 0; e < 4; ++e) {
            const float lo = (w0 * bflo(a0[e]) + w1 * bflo(a1[e]) + w2 * bflo(a2[e])) * bflo(sg[e]);
            const float hi = (w0 * bfhi(a0[e]) + w1 * bfhi(a1[e]) + w2 * bfhi(a2[e])) * bfhi(sg[e]);
            ov[e] = cvt_pk_bf16(lo, hi);
        }
        *(u32x4*)(zcat + (size_t)row * DM + chunk * 8) = ov;
    }
}

template <int KIND> __device__ __forceinline__ void gemm_stage(int i, PG8_LAS unsigned char* lds) {
    KP p = getp(); unsigned char* ws = p->ws;
    int G = gridDim.x, c = blockIdx.x; asm volatile("" : "+s"(G), "+s"(c));
    bf16_t* xb = (bf16_t*)(ws + WS_XB); float* hbuf = (float*)(ws + WS_H); float* rss = (float*)(ws + WS_RSS);
    bf16_t* proj = (bf16_t*)(ws + WS_PROJ); bf16_t* zcat = (bf16_t*)(ws + WS_ZCAT);
    const f32x4* csrc = nullptr; f32x4* cdst = nullptr;
    if (G == 256) { const int chunk = c >> 3, part = c & 7, kv = chunk >> 4, ib = chunk & 15;
        csrc = (const f32x4*)(p->in[kv ? I_CV : I_CK] + ((size_t)ib * 2048 + 4) * 2048) + (size_t)part * CP_PER_WG;
        cdst = (f32x4*)(p->out + (kv ? O_VS : O_KS) + (size_t)ib * 2048 * 2048) + (size_t)part * CP_PER_WG; }
    const int seq0 = i * 9 + (KIND == 0 ? 0 : KIND == 1 ? 3 : KIND == 2 ? 4 : 8);
#ifdef STAGGER_TICKS
    if ((KIND == 0 || KIND == 2) && (c & 1)) {
        const unsigned long long t0 = __builtin_amdgcn_s_memrealtime();
        while (__builtin_amdgcn_s_memrealtime() - t0 < STAGGER_TICKS) __builtin_amdgcn_s_sleep(8);
    }
#endif
    if constexpr (KIND == 0) {
        const bf16_t* Wt = (const bf16_t*)(ws + WS_WINAB) + (size_t)i * NAB * DM;
        pg8::Gemm g{xb, Wt, MP, NAB, DM}; pg8::StaticOrder S; S.init(MP, NAB, G, c);
        EpiMain<QInAB> E{{rss + (2 * i) * MT, proj, nullptr}, csrc, cdst, seq0};
        pg8::gemm_phase<EpiMain<QInAB>, pg8::StaticOrder, false>(lds, g, S, E, nullptr);
        skinny_gemm<QInAB>(xb, Wt, NAB, E.q, (LAS char*)lds);
    } else if constexpr (KIND == 1) {
        const bf16_t* Wt = (const bf16_t*)(ws + WS_WOUTAB) + (size_t)i * DM * DM;
        pg8::Gemm g{zcat, Wt, MP, DM, DM}; pg8::StaticOrder S; S.init(MP, DM, G, c);
        if (i == 0) { typedef QOut<0, 0, 1> QT; EpiMain<QT> E{{p->in[I_XP], p->in[I_XS], hbuf, xb, rss + (2 * i + 1) * MT}, csrc, cdst, seq0};
            pg8::gemm_phase<EpiMain<QT>, pg8::StaticOrder, false>(lds, g, S, E, nullptr); skinny_gemm<QT>(zcat, Wt, DM, E.q, (LAS char*)lds); }
        else { typedef QOut<1, 0, 1> QT; EpiMain<QT> E{{nullptr, nullptr, hbuf, xb, rss + (2 * i + 1) * MT}, csrc, cdst, seq0};
            pg8::gemm_phase<EpiMain<QT>, pg8::StaticOrder, false>(lds, g, S, E, nullptr); skinny_gemm<QT>(zcat, Wt, DM, E.q, (LAS char*)lds); }
    } else if constexpr (KIND == 2) {
        const bf16_t* Wt = (const bf16_t*)(ws + WS_WINC) + (size_t)i * NC * DM;
        pg8::Gemm g{xb, Wt, MP, NC, DM}; pg8::StaticOrder S; S.init(MP, NC, G, c);
        float* out = p->out;
        EpiMain<QInC> E{{rss + (2 * i + 1) * MT, proj, (bf16_t*)(ws + WS_QS), out + O_KP + (size_t)i * 2 * 2048 * 2048, out + O_KS + (size_t)i * 8 * 2048 * 2048,
                         out + O_VP + (size_t)i * 2 * 2048 * 2048, out + O_VS + (size_t)i * 8 * 2048 * 2048, nullptr}, csrc, cdst, seq0};
        pg8::gemm_phase<EpiMain<QInC>, pg8::StaticOrder, false>(lds, g, S, E, nullptr);
        skinny_gemm<QInC>(xb, Wt, NC, E.q, (LAS char*)lds);
    } else {
        const bf16_t* Wt = (const bf16_t*)(ws + WS_WOUTC) + (size_t)i * DM * DM;
        pg8::Gemm g{zcat, Wt, MP, DM, DM}; pg8::StaticOrder S; S.init(MP, DM, G, c);
        if (i == 0) { typedef QOut<1, 0, 1> QT; EpiMain<QT> E{{nullptr, nullptr, hbuf, xb, rss + (2 * i + 2) * MT}, csrc, cdst, seq0};
            pg8::gemm_phase<EpiMain<QT>, pg8::StaticOrder, false>(lds, g, S, E, nullptr); skinny_gemm<QT>(zcat, Wt, DM, E.q, (LAS char*)lds); }
        else { typedef QOut<1, 1, 0> QT; EpiMain<QT> E{{nullptr, nullptr, hbuf, xb, rss + (2 * i + 2) * MT}, csrc, cdst, seq0};
            pg8::gemm_phase<EpiMain<QT>, pg8::StaticOrder, false>(lds, g, S, E, nullptr); skinny_gemm<QT>(zcat, Wt, DM, E.q, (LAS char*)lds); }
    }
}
__device__ __forceinline__ void final_phase() {
    KP p = getp();
    const float* hbuf = (const float*)(p->ws + WS_H); const float* rss = (const float*)(p->ws + WS_RSS); float* out = p->out;
    const int tid = ltid(), wid = tid >> 6, lane = tid & 63;
    const float* fw = p->in[I_FNW];
    for (int row = blockIdx.x * 8 + wid; row < MT; row += gridDim.x * 8) {
        const float rs = rsqrtf(rss[4 * MT + row] * (1.f / 2048.f) + 1e-6f);
#pragma unroll
        for (int k = 0; k < 8; ++k) {
            const int col = (k * 64 + lane) * 4;
            const f32x4 v = *(const f32x4*)(hbuf + (size_t)row * DM + col), w = *(const f32x4*)(fw + col);
            __builtin_nontemporal_store(v * rs * w, (f32x4*)(out + (size_t)row * DM + col));
        }
    }
}
__device__ __forceinline__ void gsync_xcd(LAS char* lds) {
    KP p = getp();
    XcdBarrier b; b.bar = (unsigned*)(p->ws + WS_BAR); b.x = xb_xcc_id(); b.st = (volatile LAS unsigned*)(lds + ST_OFF);
    xcd_barrier(b);
}
#define GSYNC() gsync_xcd(lds)
__global__ void __launch_bounds__(512) hybrid_fwd(Params pdummy) {
    extern __shared__ __attribute__((aligned(16))) unsigned char lds_raw[];
    LAS char* lds = (LAS char*)lds_raw;
    PG8_LAS unsigned char* glds = (PG8_LAS unsigned char*)lds_raw;
    cg::grid_group grid = cg::this_grid();
    {
        if (threadIdx.x == 0) { ((volatile LAS unsigned*)(lds + ST_OFF))[0] = 0u; ((volatile LAS unsigned*)(lds + ST_OFF))[1] = 0u; }
        __syncthreads();
        KP p0 = getp();
        (void)xcd_barrier_post((unsigned*)(p0->ws + WS_BAR), (volatile LAS unsigned*)(lds + ST_OFF));
    }
#ifndef SKIP_P0
    phase0(lds);
#ifdef PROBE_P02
    GSYNC(); phase0(lds);
#endif
#endif
    grid.sync();
    for (int i = 0; i < 2; ++i) {
#ifndef SKIP_G1
        gemm_stage<0>(i, glds);
#ifdef PROBE_G2X
        GSYNC(); gemm_stage<0>(i, glds);
#endif
#endif
        GSYNC();
#ifndef SKIP_MIX
        mixer_phase(i, lds);
#ifdef PROBE_MIX2
        GSYNC(); mixer_phase(i, lds);
#endif
#endif
        GSYNC();
#ifndef SKIP_G2
        gemm_stage<1>(i, glds);
#endif
        GSYNC();
#ifndef SKIP_G3
        gemm_stage<2>(i, glds);
#ifdef PROBE_G2X
        GSYNC(); gemm_stage<2>(i, glds);
#endif
#endif
        GSYNC();
#ifndef SKIP_ATT
        attn_phase(i, lds);
        GSYNC();
        attn_merge_phase();
#endif
        GSYNC();
#ifndef SKIP_G4
        gemm_stage<3>(i, glds);
#endif
        GSYNC();
    }
    final_phase();
}

extern "C" void kernel_launch(void* const* d_in, const int* in_sizes, int n_in, void* d_out, int out_size, void* d_ws, size_t ws_size, hipStream_t stream) {
    static int grid = 0;
    if (grid == 0) {
        if (n_in != 15 || (size_t)out_size != O_END || ws_size < WS_END) { fprintf(stderr, "kernel_launch: unexpected shapes (n_in %d out %d ws %zu, need %zu / %zu)\n", n_in, out_size, ws_size, (size_t)O_END, (size_t)WS_END); grid = -1; return; }
        int dev = 0, cus = 0, per_cu = 0;
        hipGetDevice(&dev); hipDeviceGetAttribute(&cus, hipDeviceAttributeMultiprocessorCount, dev);
        if (hipFuncSetAttribute((const void*)hybrid_fwd, hipFuncAttributeMaxDynamicSharedMemorySize, LDS_BYTES) != hipSuccess) { fprintf(stderr, "kernel_launch: hipFuncSetAttribute failed\n"); grid = -1; return; }
        if (hipOccupancyMaxActiveBlocksPerMultiprocessor(&per_cu, (const void*)hybrid_fwd, 512, LDS_BYTES) != hipSuccess || per_cu < 1) { fprintf(stderr, "kernel_launch: occupancy query says %d blocks per CU\n", per_cu); (void)hipGetLastError(); grid = -1; return; }
        grid = cus;
    }
    if (grid < 0) return;
    Params prm{};
    for (int i = 0; i < 15; ++i) prm.in[i] = (const float*)d_in[i];
    prm.out = (float*)d_out; prm.ws = (unsigned char*)d_ws;
    if (hipMemsetAsync((char*)d_ws + WS_BAR, 0, (size_t)XCD_BAR_WORDS * 4, stream) != hipSuccess) { fprintf(stderr, "kernel_launch: memset of the barrier words failed\n"); return; }
    void* args[] = {&prm};
    hipError_t e = hipLaunchCooperativeKernel((const void*)hybrid_fwd, dim3(grid), dim3(512), args, LDS_BYTES, stream);
    if (e != hipSuccess) fprintf(stderr, "cooperative launch failed: %s (grid %d)\n", hipGetErrorString(e), grid);
}
```

```cpp
#include <hip/hip_runtime.h>
#include <hip/hip_cooperative_groups.h>
#include <cstdio>
#include <cstdint>
namespace cg = cooperative_groups;
namespace pg8 {
#define PG8_LAS __attribute__((address_space(3)))
typedef unsigned short bf16_t;
typedef short bf16x8 __attribute__((ext_vector_type(8)));
typedef float f32x4 __attribute__((ext_vector_type(4)));
typedef unsigned u32x4 __attribute__((ext_vector_type(4)));
constexpr int BM = 256, BK = 64, HALF = 128, HTB = HALF * BK * 2  , STAGE_BYTES = 8 * HTB, NXCD = 8, WGM = 8;

__host__ __device__ __forceinline__ int lds_byte(int r, int c) { const int st = (r >> 4) * 2 + (c >> 5), rr = r & 15, cc = c & 31, ob = rr * 64 + cc * 2; return st * 1024 + (ob ^ (((ob >> 9) & 1) << 5)); }
__host__ __device__ __forceinline__ void stage_rc(int b, int& R, int& C) { const int st = b / 1024, sb = b % 1024, swz = sb ^ (((sb >> 9) & 1) << 5); R = (st >> 1) * 16 + swz / 64; C = (st & 1) * 32 + (swz % 64) / 2; }
__host__ __device__ __forceinline__ int perm32(int rho) { const int n = rho >> 4, i = rho & 15; return 8 * (i >> 2) + 4 * n + (i & 3); }

struct Unit { int pm, pn; };
struct Gemm { const bf16_t* A; const bf16_t* Bt; int M, N, K; };

struct StaticOrder {
    int nM, nN, nwg, G, c;
    __host__ __device__ void init(int M, int N, int G_, int c_) { nM = M / BM; nN = N / BM; nwg = nM * nN; G = G_; c = c_; }
    __host__ __device__ bool next(int i, Unit& u) const {
        const long L = (long)i * G + c; if (L >= nwg) return false;
        int wgid = (int)L; { const int q = nwg / NXCD, r = nwg % NXCD, xcd = wgid % NXCD, off = wgid / NXCD; wgid = (xcd < r ? xcd * (q + 1) : r * (q + 1) + (xcd - r) * q) + off; }
        const int nig = WGM * nN, gid = wgid / nig, fm = gid * WGM, gsz = (nM - fm) < WGM ? (nM - fm) : WGM;
        u.pm = fm + ((wgid % nig) % gsz); u.pn = (wgid % nig) / gsz; return true;
    }
    __device__ __forceinline__ void a_ready(const Unit&) const {}
    __device__ __forceinline__ void done(const Unit&) const {}
};
__device__ __forceinline__ unsigned cvt_pk_bf16(float lo, float hi) { unsigned r; asm volatile("v_cvt_pk_bf16_f32 %0, %1, %2" : "=v"(r) : "v"(lo), "v"(hi)); return r; }
template <class Epi, class Sched, bool STAMP = false>
__device__ __forceinline__ void gemm_phase(PG8_LAS unsigned char* lds, const Gemm g, const Sched& S, const Epi& E, unsigned long long* stamps) {
    int tid_l = threadIdx.x; asm volatile("" : "+v"(tid_l)); const int tid = tid_l, wid = __builtin_amdgcn_readfirstlane(tid >> 6), lane = tid & 63, wr = wid >> 2, wc = wid & 3, fr = lane & 15, fq = lane >> 4;
    const int K = g.K, nt = K / BK;
    int ts_lo = 0, ts_hi = 0, nts = 0; const unsigned long long rt_entry = STAMP ? (unsigned long long)wall_clock64() : 0ull;
#define PG8_STAMP() do { if (STAMP && wid == 0 && nts < 64) { const unsigned long long _c = (unsigned long long)clock64(); \
        ts_lo = (lane == nts) ? (int)(unsigned)_c : ts_lo; ts_hi = (lane == nts) ? (int)(unsigned)(_c >> 32) : ts_hi; ++nts; } } while (0)
    PG8_STAMP();
    unsigned voffA[2], voffB[2];
#pragma unroll
    for (int i = 0; i < 2; ++i) { int R, C; stage_rc(tid * 16 + i * 8192, R, C); const int Rb = Epi::PERM ? ((R & ~31) + perm32(R & 31)) : R;
        voffA[i] = (unsigned)(R * K + C) * 2u; voffB[i] = (unsigned)(Rb * K + C) * 2u; }
    const size_t kstep = (size_t)(BK * 2);
    const size_t hstep = (size_t)HALF * K * 2;
    const size_t tstep = 2 * hstep;
    const unsigned ldsw = (unsigned)wid * 1024u;
    const int aoff = lds_byte(wr * 64 + fr, fq * 8), boff = lds_byte(wc * 32 + fr, fq * 8);
#define PG8_SA(b, h) (((b) * 2 + (h)) * HTB)
#define PG8_SB(b, h) ((4 + (b) * 2 + (h)) * HTB)
#define PG8_STAGE(bufoff, gbase, voff) do { _Pragma("unroll") for (int _i = 0; _i < 2; ++_i) \
        __builtin_amdgcn_global_load_lds((const unsigned*)((const char*)(gbase) + (voff)[_i]), (PG8_LAS unsigned*)(lds + (bufoff) + ldsw + _i * 8192), 16, 0, 0); } while (0)
#define PG8_LDA(dst, b, h) do { _Pragma("unroll") for (int m = 0; m < 4; ++m) _Pragma("unroll") for (int k = 0; k < 2; ++k) dst[m][k] = *(const PG8_LAS bf16x8*)(lds + PG8_SA(b, h) + aoff + m * 2048 + k * 1024); } while (0)
#define PG8_LDB(dst, b, h) do { _Pragma("unroll") for (int n = 0; n < 2; ++n) _Pragma("unroll") for (int k = 0; k < 2; ++k) dst[n][k] = *(const PG8_LAS bf16x8*)(lds + PG8_SB(b, h) + boff + n * 2048 + k * 1024); } while (0)
#define PG8_MMA(ai, bj, At, Bt) do { __builtin_amdgcn_s_setprio(1); _Pragma("unroll") for (int m = 0; m < 4; ++m) _Pragma("unroll") for (int n = 0; n < 2; ++n) _Pragma("unroll") for (int k = 0; k < 2; ++k) \
        acc[ai][bj][m][n] = __builtin_amdgcn_mfma_f32_16x16x32_bf16(Bt[n][k], At[m][k], acc[ai][bj][m][n], 0, 0, 0); __builtin_amdgcn_s_setprio(0); } while (0)
#define PG8_WAIT_V(n) asm volatile("s_waitcnt vmcnt(" #n ")" ::: "memory")
#define PG8_WAIT_L(n) asm volatile("s_waitcnt lgkmcnt(" #n ")" ::: "memory")
#define PG8_BAR __builtin_amdgcn_s_barrier()
#define PG8_SCHED __builtin_amdgcn_sched_barrier(0)
    Unit cur, nxt; int ui = 0;
    if (!S.next(0, cur)) return;
    f32x4 acc[2][2][4][2];
    if constexpr (Epi::HAS_INIT) E.init(acc, cur, wr, wc, fr, fq); else {
#pragma unroll
    for (int a = 0; a < 2; ++a)
#pragma unroll
        for (int b = 0; b < 2; ++b)
#pragma unroll
            for (int m = 0; m < 4; ++m)
#pragma unroll
                for (int n = 0; n < 2; ++n) acc[a][b][m][n] = (f32x4){0.f, 0.f, 0.f, 0.f};
    }
    bf16x8 At[4][2], B0[2][2], B1[2][2];
    const char* cA = (const char*)g.A + (size_t)cur.pm * tstep; const char* cB = (const char*)g.Bt + (size_t)cur.pn * tstep;
    S.a_ready(cur);
    PG8_STAGE(PG8_SB(0, 0), cB, voffB); PG8_STAGE(PG8_SA(0, 0), cA, voffA); PG8_STAGE(PG8_SB(0, 1), cB + hstep, voffB); PG8_STAGE(PG8_SA(0, 1), cA + hstep, voffA);
    if (wr == 1) PG8_BAR;
    PG8_WAIT_V(4); PG8_BAR;
    PG8_STAGE(PG8_SB(1, 0), cB + kstep, voffB); PG8_STAGE(PG8_SA(1, 0), cA + kstep, voffA); PG8_STAGE(PG8_SB(1, 1), cB + hstep + kstep, voffB);
    PG8_WAIT_V(6); PG8_BAR;
    PG8_STAMP();
    for (;;) {
        const bool has_next = S.next(ui + 1, nxt);
        const char* nA = has_next ? (const char*)g.A + (size_t)nxt.pm * tstep : cA; const char* nB = has_next ? (const char*)g.Bt + (size_t)nxt.pn * tstep : cB;
        for (int t = 0; t < nt; t += 2) {
            const bool last = (t == nt - 2);
            const char* a1 = cA + (size_t)(t + 1) * kstep;
            const char* a2 = last ? nA : cA + (size_t)(t + 2) * kstep; const char* b2 = last ? nB : cB + (size_t)(t + 2) * kstep;
            const char* a3 = a2 + kstep; const char* b3 = b2 + kstep;
            if (last && has_next) S.a_ready(nxt);
            PG8_LDB(B0, 0, 0); PG8_SCHED; PG8_LDA(At, 0, 0); PG8_STAGE(PG8_SA(1, 1), a1 + hstep, voffA);
            PG8_WAIT_L(8); PG8_BAR; PG8_WAIT_L(0); PG8_MMA(0, 0, At, B0); PG8_BAR; PG8_SCHED;
            PG8_LDB(B1, 0, 1); PG8_STAGE(PG8_SB(0, 0), b2, voffB);
            PG8_BAR; PG8_WAIT_L(0); PG8_MMA(0, 1, At, B1); PG8_BAR;
            PG8_LDA(At, 0, 1); PG8_STAGE(PG8_SA(0, 0), a2, voffA);
            PG8_BAR; PG8_WAIT_L(0); PG8_MMA(1, 0, At, B0); PG8_BAR; PG8_SCHED;
            PG8_STAGE(PG8_SB(0, 1), b2 + hstep, voffB);
            PG8_WAIT_V(6); PG8_BAR; PG8_MMA(1, 1, At, B1); PG8_BAR;
            PG8_LDB(B0, 1, 0); PG8_SCHED; PG8_LDA(At, 1, 0); PG8_STAGE(PG8_SA(0, 1), a2 + hstep, voffA);
            PG8_WAIT_L(8); PG8_BAR; PG8_WAIT_L(0); PG8_MMA(0, 0, At, B0); PG8_BAR; PG8_SCHED;
            PG8_LDB(B1, 1, 1); PG8_STAGE(PG8_SB(1, 0), b3, voffB);
            PG8_BAR; PG8_WAIT_L(0); PG8_MMA(0, 1, At, B1); PG8_BAR;
            PG8_LDA(At, 1, 1); PG8_STAGE(PG8_SA(1, 0), a3, voffA);
            PG8_BAR; PG8_WAIT_L(0); PG8_MMA(1, 0, At, B0); PG8_BAR; PG8_SCHED;
            PG8_STAGE(PG8_SB(1, 1), b3 + hstep, voffB);
            PG8_WAIT_V(6); PG8_BAR; PG8_MMA(1, 1, At, B1); PG8_BAR;
        }
        PG8_STAMP();
        if constexpr (!Epi::AFTER_DRAIN) { E(acc, cur, wr, wc, fr, fq); S.done(cur); }
        PG8_STAMP();
        if (!has_next) break;
        if constexpr (Epi::HAS_INIT) E.init(acc, nxt, wr, wc, fr, fq); else {
#pragma unroll
        for (int a = 0; a < 2; ++a)
#pragma unroll
            for (int b = 0; b < 2; ++b)
#pragma unroll
                for (int m = 0; m < 4; ++m)
#pragma unroll
                    for (int n = 0; n < 2; ++n) acc[a][b][m][n] = (f32x4){0.f, 0.f, 0.f, 0.f};
        }
        cur = nxt; cA = nA; cB = nB; ++ui;
    }
    PG8_WAIT_V(0);
    if (wr == 0) PG8_BAR;
    PG8_BAR;
    if constexpr (Epi::AFTER_DRAIN) { E.fused(acc, cur, wr, wc, fr, fq, lds, wid, lane); S.done(cur); }
    PG8_STAMP();
    if (STAMP && wid == 0) { stamps[lane] = lane < nts ? (((unsigned long long)(unsigned)ts_hi << 32) | (unsigned)ts_lo) : 0ull;
        if (lane == 62) stamps[62] = rt_entry; if (lane == 63) stamps[63] = (unsigned long long)wall_clock64(); }
#undef PG8_STAMP
#undef PG8_SA
#undef PG8_SB
#undef PG8_STAGE
#undef PG8_LDA
#undef PG8_LDB
#undef PG8_MMA
#undef PG8_WAIT_V
#undef PG8_WAIT_L
#undef PG8_BAR
#undef PG8_SCHED
}
}

#define LAS __attribute__((address_space(3)))
typedef unsigned short bf16_t;
typedef short bf16x8 __attribute__((ext_vector_type(8)));
typedef short s16x4 __attribute__((ext_vector_type(4)));
typedef short v4i16_t __attribute__((ext_vector_type(4)));
typedef float f32x4 __attribute__((ext_vector_type(4)));
typedef float f32x2 __attribute__((ext_vector_type(2)));
typedef float f32x16 __attribute__((ext_vector_type(16)));
typedef unsigned u32x4 __attribute__((ext_vector_type(4)));
typedef unsigned u32x2 __attribute__((ext_vector_type(2)));
using pg8::cvt_pk_bf16;

#define XB_TMO      128
#define XB_XCNT(j)  (256  + 64 * (j))
#define XB_XSUB(j)  (1280 + 64 * (j))
#define XB_XGEN(j)  (2304 + 64 * (j))
#define XB_TOP      3328
#define XB_TOPGEN   3392
#define XCD_BAR_WORDS 3456
#define XB_SPIN_CAP (1u << 18)

__device__ __forceinline__ unsigned xb_ld(unsigned* p)              { return __hip_atomic_load(p, __ATOMIC_RELAXED, __HIP_MEMORY_SCOPE_AGENT); }
__device__ __forceinline__ unsigned xb_add(unsigned* p, unsigned v) { return __hip_atomic_fetch_add(p, v, __ATOMIC_RELAXED, __HIP_MEMORY_SCOPE_AGENT); }
__device__ __forceinline__ unsigned xb_xcc_id() { return (unsigned)__builtin_amdgcn_s_getreg((3 << 11) | 20) & 0xFu; }
#define XB_SPIN(cond, bar) do { unsigned _sp = 0; while (cond) { __builtin_amdgcn_s_sleep(1); \
    if ((++_sp & 255u) == 0u) { if (xb_ld(&(bar)[XB_TMO])) break; if (_sp > XB_SPIN_CAP) { atomicAdd(&(bar)[XB_TMO], 1u); break; } } } } while (0)

struct XcdBarrier {
    unsigned* bar; unsigned x;
    volatile LAS unsigned* st;
};

__device__ __forceinline__ XcdBarrier xcd_barrier_post(unsigned* bar, volatile LAS unsigned* st) {
    XcdBarrier b; b.bar = bar; b.x = xb_xcc_id(); b.st = st;
    if (threadIdx.x == 0) (void)xb_add(&bar[XB_XCNT(b.x)], 1u);
    return b;
}
__device__ __forceinline__ void xcd_barrier_complete(unsigned* bar, unsigned x, unsigned& nloc, unsigned& nx) {
    const unsigned G = gridDim.x * gridDim.y * gridDim.z;
    unsigned sum, cnt, mine, sp = 0u;
    for (;;) {
        sum = 0u; cnt = 0u; mine = 0u;
#pragma unroll
        for (unsigned j = 0; j < 16; ++j) { const unsigned c = xb_ld(&bar[XB_XCNT(j)]); sum += c; cnt += (c > 0u) ? 1u : 0u; mine = (j == x) ? c : mine; }
        if (sum == G) break;
        __builtin_amdgcn_s_sleep(1);
        if ((++sp & 255u) == 0u) { if (xb_ld(&bar[XB_TMO])) break; if (sp > XB_SPIN_CAP) { atomicAdd(&bar[XB_TMO], 1u); break; } }
    }
    nloc = mine > 0u ? mine : 1u; nx = cnt > 0u ? cnt : 1u;
}

__device__ __forceinline__ void xcd_barrier(const XcdBarrier& b) {
    asm volatile("s_waitcnt vmcnt(0)" ::: "memory");
    __syncthreads();
    if (threadIdx.x == 0) {
        unsigned* bar = b.bar;
        __builtin_amdgcn_s_waitcnt(0);
        unsigned nloc = b.st[0], nx = b.st[1];
        if (nloc == 0u) { xcd_barrier_complete(bar, b.x, nloc, nx); b.st[0] = nloc; b.st[1] = nx; }
        const unsigned old = xb_add(&bar[XB_XSUB(b.x)], 1u);
        const unsigned gen = old / nloc;
        if (old + 1u == (gen + 1u) * nloc) {
            __builtin_amdgcn_fence(__ATOMIC_RELEASE, "agent");
            asm volatile("s_waitcnt vmcnt(0)" ::: "memory");
            const unsigned og = xb_add(&bar[XB_TOP], 1u);
            const unsigned tg = og / nx;
            if (og + 1u == (tg + 1u) * nx) xb_add(&bar[XB_TOPGEN], 1u);
            else XB_SPIN(xb_ld(&bar[XB_TOPGEN]) == tg, bar);
            __builtin_amdgcn_fence(__ATOMIC_ACQUIRE, "agent");
            xb_add(&bar[XB_XGEN(b.x)], 1u);
            asm volatile("s_waitcnt vmcnt(0)" ::: "memory");
        } else {
            XB_SPIN(xb_ld(&bar[XB_XGEN(b.x)]) == gen, bar);
            __builtin_amdgcn_fence(__ATOMIC_ACQUIRE, "agent");
            asm volatile("s_waitcnt vmcnt(0)" ::: "memory");
        }
    }
    __syncthreads();
}

constexpr int DM = 2048, MP = 8192, MS = 32, MT = MP + MS;
constexpr int NAB = 6144, NC = 8192;
constexpr size_t al256(size_t x) { return (x + 255) & ~(size_t)255; }
constexpr size_t WS_XB = 0;
constexpr size_t WS_H = al256(WS_XB + (size_t)MT * DM * 2);
constexpr size_t WS_RSS = al256(WS_H + (size_t)MT * DM * 4);
constexpr size_t WS_PROJ = al256(WS_RSS + (size_t)5 * MT * 4);
constexpr size_t WS_ZCAT = al256(WS_PROJ + (size_t)MT * NC * 2);
constexpr size_t WS_OG = al256(WS_ZCAT + (size_t)MT * DM * 2);
constexpr size_t WS_LSE = al256(WS_OG + (size_t)3 * MP * DM * 2);
constexpr size_t WS_WINAB = al256(WS_LSE + (size_t)3 * MP * 16 * 4);
constexpr size_t WS_WOUTAB = al256(WS_WINAB + (size_t)2 * NAB * DM * 2);
constexpr size_t WS_WINC = al256(WS_WOUTAB + (size_t)2 * DM * DM * 2);
constexpr size_t WS_WOUTC = al256(WS_WINC + (size_t)2 * NC * DM * 2);
constexpr size_t WS_PLIN = al256(WS_WOUTC + (size_t)2 * DM * DM * 2);
constexpr size_t WS_QS = al256(WS_PLIN + (size_t)2 * 4 * 256 * 256 * 2);
constexpr size_t WS_BAR = al256(WS_QS + (size_t)32 * 2048 * 2);
constexpr size_t WS_END = al256(WS_BAR + (size_t)XCD_BAR_WORDS * 4);
constexpr size_t HM = (size_t)2 * 16 * 4096 * 128;
constexpr size_t WS_QH = WS_PROJ, WS_KH = WS_QH + HM * 2, WS_VH = WS_KH + HM * 2, WS_SG = WS_VH + HM * 2;
static_assert(WS_SG + (size_t)MT * DM * 2 <= WS_ZCAT, "C-layer buffers must fit the proj region");
constexpr size_t O_YP = 0, O_YS = O_YP + (size_t)MP * DM, O_PP = O_YS + (size_t)MS * DM, O_PS = O_PP + 2 * 2 * 15 * 1024, O_CP = O_PS + 2 * 8 * 15 * 1024,
                 O_CS = O_CP + 2 * 2 * 2 * 1024, O_KP = O_CS + 2 * 8 * 2 * 1024, O_KS = O_KP + (size_t)2 * 2 * 2048 * 2048, O_VP = O_KS + (size_t)2 * 8 * 2048 * 2048,
                 O_VS = O_VP + (size_t)2 * 2 * 2048 * 2048, O_END = O_VS + (size_t)2 * 8 * 2048 * 2048;
constexpr int LDS_BYTES = 163840;
constexpr int ST_OFF = LDS_BYTES - 16;
constexpr float QSCALE = 0.08838834764831845f * 1.4426950408889634f;

struct Params { const float* in[15]; float* out; unsigned char* ws; };
__device__ __forceinline__ int ltid() { int t = threadIdx.x; asm volatile("" : "+v"(t)); return t; }
__device__ __forceinline__ int lbid() { int t = blockIdx.x; asm volatile("" : "+s"(t)); return t; }
typedef const __attribute__((address_space(4))) Params* KP;
__device__ __forceinline__ KP getp() { KP pp = (KP)__builtin_amdgcn_kernarg_segment_ptr(); asm volatile("" : "+s"(pp)); return pp; }
enum { I_XP = 0, I_XS, I_SPOOL, I_SCONV, I_CK, I_CV, I_NW, I_FNW, I_WINAB, I_PLIN, I_PSCALE, I_CONVW, I_WOUTAB, I_WINC, I_WOUTC };

__device__ __forceinline__ float bf2f(bf16_t b) { return __uint_as_float(((unsigned)b) << 16); }
__device__ __forceinline__ float bflo(unsigned w) { return __uint_as_float(w << 16); }
__device__ __forceinline__ float bfhi(unsigned w) { return __uint_as_float(w & 0xffff0000u); }
__device__ __forceinline__ float silu_f(float x) { return x / (1.f + __expf(-x)); }
__device__ __forceinline__ float wave_sum(float v) {
#pragma unroll
    for (int o = 32; o >= 1; o >>= 1) v += __shfl_xor(v, o);
    return v; }
__device__ __forceinline__ float wave_max(float v) {
#pragma unroll
    for (int o = 32; o >= 1; o >>= 1) v = fmaxf(v, __shfl_xor(v, o));
    return v; }

constexpr int NABO = 4096;
struct QInABtag {}; struct QInAB {
    static constexpr bool NEED_SS = false, RES_EPI = false, INIT = false;
    const float* rss; bf16_t* proj; float* rss_next;
    __device__ __forceinline__ float rowscale(int row) const { return rsqrtf(rss[row] * (1.f / 2048.f) + 1e-6f); }
    __device__ __forceinline__ void pair(int row, int col, f32x4 v0, f32x4 v1, float rs, float& ss) const {
        v0 *= rs; v1 *= rs;
        bf16_t* dst = proj + (size_t)row * NABO;
        if (col < 2048) {
            if (col >= 1024) {
#pragma unroll
                for (int e = 0; e < 4; ++e) { v0[e] = silu_f(v0[e]); v1[e] = silu_f(v1[e]); }
            }
            u32x4 w; w.x = cvt_pk_bf16(v0[0], v0[1]); w.y = cvt_pk_bf16(v0[2], v0[3]); w.z = cvt_pk_bf16(v1[0], v1[1]); w.w = cvt_pk_bf16(v1[2], v1[3]);
            *(u32x4*)(dst + col) = w;
        } else {
            const int second = col >= 4096, ch = ((col - 2048) & 2047) >> 1;
            if (second) {
#pragma unroll
                for (int e = 0; e < 4; ++e) v1[e] = silu_f(v1[e]);
            }
            const f32x4 z = v0 * v1;
            u32x2 w; w.x = cvt_pk_bf16(z[0], z[1]); w.y = cvt_pk_bf16(z[2], z[3]); *(u32x2*)(dst + 2048 + second * 1024 + ch) = w;
        }
    }
    __device__ __forceinline__ void pair_main(int row, int col, f32x4 v0, f32x4 v1, float rs, float& ss) const { pair(row, col, v0, v1, rs, ss); }
};
struct QInC {
    static constexpr bool NEED_SS = false, RES_EPI = false, INIT = false;
    const float* rss; bf16_t* qh; bf16_t* qs; float* kp; float* ks; float* vp; float* vs; float* rss_next;
    __device__ __forceinline__ float rowscale(int row) const { return rsqrtf(rss[row] * (1.f / 2048.f) + 1e-6f); }
    __device__ __forceinline__ void pair(int row, int col, f32x4 v0, f32x4 v1, float rs, float& ss) const {
        v0 *= rs; v1 *= rs;
        const int seg = col >> 11, cc = col & 2047;
        if (seg == 1 || seg == 2) {
            float* dst;
            if (row < MP) { const int b = row >> 12, t = row & 4095; dst = (t >= 2048) ? ((seg == 1 ? kp : vp) + ((size_t)(b * 2048 + (t - 2048)) * 2048 + cc)) : nullptr; }
            else { const int r = row - MP, b = r >> 2, s = r & 3; dst = (seg == 1 ? ks : vs) + ((size_t)(b * 2048 + 2044 + s) * 2048 + cc); }
            if (dst) { __builtin_nontemporal_store(v0, (f32x4*)dst); __builtin_nontemporal_store(v1, (f32x4*)(dst + 4)); }
        }
        if (seg == 0) { v0 *= QSCALE; v1 *= QSCALE; }
        if (seg == 3) {
#pragma unroll
            for (int e = 0; e < 4; ++e) { v0[e] = silu_f(v0[e]); v1[e] = silu_f(v1[e]); }
        }
        u32x4 w; w.x = cvt_pk_bf16(v0[0], v0[1]); w.y = cvt_pk_bf16(v0[2], v0[3]); w.z = cvt_pk_bf16(v1[0], v1[1]); w.w = cvt_pk_bf16(v1[2], v1[3]);
        bf16_t* d2;
        if (seg == 3) d2 = qh + 3 * HM + (size_t)row * DM + cc;
        else if (row < MP) d2 = qh + (size_t)seg * HM + ((size_t)((row >> 12) * 16 + (cc >> 7)) * 4096 + (row & 4095)) * 128 + (cc & 127);
        else d2 = seg == 0 ? qs + (size_t)(row - MP) * DM + cc : nullptr;
        if (d2) *(u32x4*)d2 = w;
    }
    __device__ __forceinline__ void pair_main(int row, int col, f32x4 v0, f32x4 v1, float rs, float& ss) const { pair(row, col, v0, v1, rs, ss); }
};
template <int resb, int wh, int wx> struct QOut {
    static constexpr bool NEED_SS = true, RES_EPI = resb != 0, INIT = resb == 0;
    const float* hold_p; const float* hold_s; float* hbuf; bf16_t* xb; float* rss_next;
    __device__ __forceinline__ float rowscale(int) const { return 1.f; }
    __device__ __forceinline__ u32x4 res_raw(int row, int col) const { return *(const u32x4*)(xb + (size_t)row * DM + col); }
    __device__ __forceinline__ void pair_res(int row, int col, f32x4 v0, f32x4 v1, u32x4 w, float& ss) const {
        pair_main(row, col, v0 + (f32x4){bflo(w.x), bfhi(w.x), bflo(w.y), bfhi(w.y)}, v1 + (f32x4){bflo(w.z), bfhi(w.z), bflo(w.w), bfhi(w.w)}, 1.f, ss); }
    __device__ __forceinline__ void load_res8(int row, int col, f32x4& r0, f32x4& r1) const {
        if (resb) { const u32x4 w = *(const u32x4*)(xb + (size_t)row * DM + col); r0 = (f32x4){bflo(w.x), bfhi(w.x), bflo(w.y), bfhi(w.y)}; r1 = (f32x4){bflo(w.z), bfhi(w.z), bflo(w.w), bfhi(w.w)}; }
        else { const float* src = (row < MP ? hold_p + (size_t)row * DM : hold_s + (size_t)(row - MP) * DM) + col; r0 = *(const f32x4*)src; r1 = *(const f32x4*)(src + 4); }
    }
    __device__ __forceinline__ void pair_main(int row, int col, f32x4 o0, f32x4 o1, float rs, float& ss) const {
        if (wh) { float* hd = hbuf + (size_t)row * DM + col; *(f32x4*)hd = o0; *(f32x4*)(hd + 4) = o1; }
        if (wx) { u32x4 w; w.x = cvt_pk_bf16(o0[0], o0[1]); w.y = cvt_pk_bf16(o0[2], o0[3]); w.z = cvt_pk_bf16(o1[0], o1[1]); w.w = cvt_pk_bf16(o1[2], o1[3]);
                  *(u32x4*)(xb + (size_t)row * DM + col) = w; }
        ss += ((o0[0] * o0[0] + o0[1] * o0[1]) + (o0[2] * o0[2] + o0[3] * o0[3])) + ((o1[0] * o1[0] + o1[1] * o1[1]) + (o1[2] * o1[2] + o1[3] * o1[3]));
    }
    __device__ __forceinline__ void pair(int row, int col, f32x4 v0, f32x4 v1, float rs, float& ss) const { f32x4 r0, r1; load_res8(row, col, r0, r1); pair_main(row, col, r0 + v0, r1 + v1, rs, ss); }
};
constexpr int CP_PER_WG = 130816, CP_PER_EPI = 7680, CP_NJ = 15;
template <class Q> struct EpiMain {
    static constexpr bool PERM = true, AFTER_DRAIN = false, HAS_INIT = Q::INIT;
    Q q; const f32x4* csrc; f32x4* cdst; mutable int seq;
    __device__ __forceinline__ void init(f32x4 (&acc)[2][2][4][2], const pg8::Unit& u, int wr, int wc, int fr, int fq) const {
        if constexpr (HAS_INIT) {
            const int row0 = u.pm * 256 + wr * 64 + fr, col0 = u.pn * 256 + wc * 32 + 8 * fq;
#pragma unroll
            for (int ai = 0; ai < 2; ++ai)
#pragma unroll
                for (int m = 0; m < 4; ++m)
#pragma unroll
                    for (int bj = 0; bj < 2; ++bj) q.load_res8(row0 + ai * 128 + m * 16, col0 + bj * 128, acc[ai][bj][m][0], acc[ai][bj][m][1]);
        }
    }
    __device__ __forceinline__ void operator()(const f32x4 (&acc)[2][2][4][2], const pg8::Unit& u, int wr, int wc, int fr, int fq) const {
        const int row0 = u.pm * 256 + wr * 64 + fr, col0 = u.pn * 256 + wc * 32 + 8 * fq;
        float rsv[2][4];
#pragma unroll
        for (int ai = 0; ai < 2; ++ai)
#pragma unroll
            for (int m = 0; m < 4; ++m) rsv[ai][m] = q.rowscale(row0 + ai * 128 + m * 16);
        asm volatile("" : "+v"(rsv[0][0]), "+v"(rsv[0][1]), "+v"(rsv[0][2]), "+v"(rsv[0][3]), "+v"(rsv[1][0]), "+v"(rsv[1][1]), "+v"(rsv[1][2]), "+v"(rsv[1][3]) :: "memory");
        f32x4 cb[8]; const int cidx = seq * CP_PER_EPI + (wr * 4 + wc) * 64 + fq * 16 + fr;
#define CP_IX(j) ((cidx + (j) * 512) < CP_PER_WG ? (cidx + (j) * 512) : CP_PER_WG - 1)
        if (csrc) {
#pragma unroll
            for (int j = 0; j < 8; ++j) cb[j] = __builtin_nontemporal_load(csrc + CP_IX(j));
        }
#pragma unroll
        for (int ai = 0; ai < 2; ++ai) {
            u32x4 rr[4][2];
            if constexpr (Q::RES_EPI) {
#pragma unroll
                for (int m = 0; m < 4; ++m)
#pragma unroll
                    for (int bj = 0; bj < 2; ++bj) rr[m][bj] = q.res_raw(row0 + ai * 128 + m * 16, col0 + bj * 128);
            }
#pragma unroll
            for (int m = 0; m < 4; ++m) {
                const int row = row0 + ai * 128 + m * 16; const float rs = rsv[ai][m]; float ss = 0.f;
#pragma unroll
                for (int bj = 0; bj < 2; ++bj) {
                    if constexpr (Q::RES_EPI) q.pair_res(row, col0 + bj * 128, acc[ai][bj][m][0], acc[ai][bj][m][1], rr[m][bj], ss);
                    else q.pair_main(row, col0 + bj * 128, acc[ai][bj][m][0], acc[ai][bj][m][1], rs, ss);
                }
                if (Q::NEED_SS) { ss += __shfl_xor(ss, 16); ss += __shfl_xor(ss, 32); if (fq == 0) atomicAdd(q.rss_next + row, ss); }
                asm volatile("" ::: "memory");
            }
            if (csrc) {
                if (ai == 0) {
#pragma unroll
                    for (int j = 0; j < 8; ++j) __builtin_nontemporal_store(cb[j], cdst + CP_IX(j));
#pragma unroll
                    for (int j = 0; j < CP_NJ - 8; ++j) cb[j] = __builtin_nontemporal_load(csrc + CP_IX(8 + j));
                } else {
#pragma unroll
                    for (int j = 0; j < CP_NJ - 8; ++j) __builtin_nontemporal_store(cb[j], cdst + CP_IX(8 + j));
                }
            }
        }
#undef CP_IX
        ++seq;
    }
};
template <class Q> __device__ __forceinline__ void skinny_gemm(const bf16_t* A, const bf16_t* Bt, int N, const Q& q, LAS char* lds) {
    const int tid = ltid(), wid = tid >> 6, lane = tid & 63, fr = lane & 15, fq = lane >> 4;
    const int ntask = N / 32;
    LAS f32x4* part = (LAS f32x4*)lds;
    for (int task = blockIdx.x; task < ntask; task += gridDim.x) {
        const int n0 = task * 32, k0 = wid * 256;
        const bf16_t* a0 = A + (size_t)(MP + fr) * DM + k0 + fq * 8; const bf16_t* a1 = a0 + (size_t)16 * DM;
        const bf16_t* b0 = Bt + (size_t)(n0 + 8 * (fr >> 2) + (fr & 3)) * DM + k0 + fq * 8; const bf16_t* b1 = b0 + (size_t)4 * DM;
        f32x4 c00 = {0.f, 0.f, 0.f, 0.f}, c01 = c00, c10 = c00, c11 = c00;
#pragma unroll
        for (int hk = 0; hk < 2; ++hk) {
            bf16x8 bv0[4], bv1[4], x0[4], x1[4];
#pragma unroll
            for (int kk = 0; kk < 4; ++kk) { const int ko = (hk * 4 + kk) * 32; bv0[kk] = *(const bf16x8*)(b0 + ko); bv1[kk] = *(const bf16x8*)(b1 + ko); x0[kk] = *(const bf16x8*)(a0 + ko); x1[kk] = *(const bf16x8*)(a1 + ko); }
#pragma unroll
            for (int kk = 0; kk < 4; ++kk) {
                c00 = __builtin_amdgcn_mfma_f32_16x16x32_bf16(bv0[kk], x0[kk], c00, 0, 0, 0); c01 = __builtin_amdgcn_mfma_f32_16x16x32_bf16(bv1[kk], x0[kk], c01, 0, 0, 0);
                c10 = __builtin_amdgcn_mfma_f32_16x16x32_bf16(bv0[kk], x1[kk], c10, 0, 0, 0); c11 = __builtin_amdgcn_mfma_f32_16x16x32_bf16(bv1[kk], x1[kk], c11, 0, 0, 0);
            }
        }
        part[(wid * 4 + 0) * 64 + lane] = c00; part[(wid * 4 + 1) * 64 + lane] = c01; part[(wid * 4 + 2) * 64 + lane] = c10; part[(wid * 4 + 3) * 64 + lane] = c11;
        __syncthreads();
        if (wid < 2) {
            f32x4 v0 = part[(wid * 2) * 64 + lane], v1 = part[(wid * 2 + 1) * 64 + lane];
#pragma unroll
            for (int w = 1; w < 8; ++w) { v0 += part[(w * 4 + wid * 2) * 64 + lane]; v1 += part[(w * 4 + wid * 2 + 1) * 64 + lane]; }
            const int row = MP + wid * 16 + fr; const float rs = q.rowscale(row); float ss = 0.f;
            q.pair(row, n0 + 8 * fq, v0, v1, rs, ss);
            if (Q::NEED_SS) { ss += __shfl_xor(ss, 16); ss += __shfl_xor(ss, 32); if (fq == 0) atomicAdd(q.rss_next + row, ss); }
        }
        __syncthreads();
    }
}

__device__ __forceinline__ int ab_dst(int n) {
    if (n < 2048) return n;
    const int seg = n >> 10, ch = n & 1023;
    return ((seg == 3 || seg == 4) ? 2048 : 4096) + (ch >> 2) * 8 + ((seg >= 4) ? 4 : 0) + (ch & 3);
}
struct ConvTile { const float* W; bf16_t* Bt; const float* sc; int ldw, K, k0, n0; };
__device__ __forceinline__ ConvTile conv_decode(KP p, int tile) {
    unsigned char* ws = p->ws; ConvTile t; int r;
    if (tile < 4608) {
        const int i = tile / 2304; r = tile % 2304; t.K = 2048;
        if (r < 768) { t.W = p->in[I_WINAB] + (size_t)i * DM * NAB; t.ldw = NAB; t.Bt = (bf16_t*)(ws + WS_WINAB) + (size_t)i * NAB * DM; t.sc = p->in[I_NW] + (2 * i) * DM; }
        else if (r < 1024) { r -= 768; t.W = p->in[I_WOUTAB] + (size_t)i * DM * DM; t.ldw = DM; t.Bt = (bf16_t*)(ws + WS_WOUTAB) + (size_t)i * DM * DM; t.sc = nullptr; }
        else if (r < 2048) { r -= 1024; t.W = p->in[I_WINC] + (size_t)i * DM * NC; t.ldw = NC; t.Bt = (bf16_t*)(ws + WS_WINC) + (size_t)i * NC * DM; t.sc = p->in[I_NW] + (2 * i + 1) * DM; }
        else { r -= 2048; t.W = p->in[I_WOUTC] + (size_t)i * DM * DM; t.ldw = DM; t.Bt = (bf16_t*)(ws + WS_WOUTC) + (size_t)i * DM * DM; t.sc = nullptr; }
    } else { const int t2 = tile - 4608, mtx = t2 >> 2; r = t2 & 3; t.K = 256; t.ldw = 256; t.W = p->in[I_PLIN] + (size_t)mtx * 65536; t.Bt = (bf16_t*)(ws + WS_PLIN) + (size_t)mtx * 65536; t.sc = nullptr; }
    const int nN = t.ldw / 256; t.k0 = (r / nN) * 64; t.n0 = (r % nN) * 256;
    return t;
}
__device__ __forceinline__ void conv_load(const ConvTile& t, f32x4 (&v)[8], float (&sv)[8], int tid) {
#pragma unroll
    for (int p = 0; p < 8; ++p) {
        const int k = p * 8 + (tid >> 6), c4 = (tid & 63) * 4;
        v[p] = __builtin_nontemporal_load((const f32x4*)(t.W + (size_t)(t.k0 + k) * t.ldw + t.n0 + c4));
        sv[p] = t.sc ? t.sc[t.k0 + k] : 1.f;
    }
}
__device__ __forceinline__ void phase0(LAS char* lds) {
    KP p = getp();
    const int tid = ltid(), wid = tid >> 6, lane = tid & 63;
    unsigned char* ws = p->ws;
    {
        constexpr int PITCH = 258;
        LAS bf16_t* T = (LAS bf16_t*)lds;
        f32x4 v[8]; float sv[8];
        int tile = blockIdx.x;
        ConvTile cur = conv_decode(p, tile < 4640 ? tile : 0);
        if (tile < 4640) conv_load(cur, v, sv, tid);
        for (; tile < 4640; tile += gridDim.x) {
#pragma unroll
            for (int q = 0; q < 8; ++q) {
                const int k = q * 8 + (tid >> 6), c4 = (tid & 63) * 4;
                const f32x4 x = v[q] * sv[q];
                LAS unsigned* d = (LAS unsigned*)(T + k * PITCH + c4);
                d[0] = cvt_pk_bf16(x[0], x[1]); d[1] = cvt_pk_bf16(x[2], x[3]);
            }
            __syncthreads();
            const int nxt_tile = tile + gridDim.x;
            const ConvTile nxt = conv_decode(p, nxt_tile < 4640 ? nxt_tile : tile);
            if (nxt_tile < 4640) conv_load(nxt, v, sv, tid);
            const bool abmap = cur.ldw == NAB;
#pragma unroll
            for (int j = 0; j < 4; ++j) {
                const int ch = tid + j * 512, n = ch >> 3, kc = ch & 7;
                unsigned w[4];
#pragma unroll
                for (int e = 0; e < 4; ++e) { const unsigned lo = T[(kc * 8 + 2 * e) * PITCH + n], hi = T[(kc * 8 + 2 * e + 1) * PITCH + n]; w[e] = lo | (hi << 16); }
                u32x4 o = {w[0], w[1], w[2], w[3]};
                *(u32x4*)(cur.Bt + (size_t)(abmap ? ab_dst(cur.n0 + n) : cur.n0 + n) * cur.K + cur.k0 + kc * 8) = o;
            }
            __syncthreads();
            cur = nxt;
        }
    }
    float* rss = (float*)(ws + WS_RSS); bf16_t* xb = (bf16_t*)(ws + WS_XB);
    const int gw = blockIdx.x * 8 + wid, nw = gridDim.x * 8;
    for (int row = gw; row < MT; row += nw) {
        const float* src = row < MP ? p->in[I_XP] + (size_t)row * DM : p->in[I_XS] + (size_t)(row - MP) * DM;
        float ss = 0.f;
#pragma unroll
        for (int i = 0; i < 8; ++i) {
            const f32x4 v = *(const f32x4*)(src + (i * 64 + lane) * 4);
            ss += (v[0] * v[0] + v[1] * v[1]) + (v[2] * v[2] + v[3] * v[3]);
            u32x2 w; w.x = cvt_pk_bf16(v[0], v[1]); w.y = cvt_pk_bf16(v[2], v[3]);
            *(u32x2*)(xb + (size_t)row * DM + (i * 64 + lane) * 4) = w;
        }
        ss = wave_sum(ss);
        if (lane == 0) rss[row] = ss;
    }
    const int gtid = blockIdx.x * 512 + tid, nth = gridDim.x * 512;
    for (int i = gtid; i < 4 * MT; i += nth) rss[MT + i] = 0.f;
    if (gridDim.x != 256) {
        constexpr int CH4 = 2044 * 2048 / 4;
        for (int c = 0; c < 32; ++c) { const int kv = c >> 4, ib = c & 15;
            const f32x4* src = (const f32x4*)(p->in[kv ? I_CV : I_CK] + ((size_t)ib * 2048 + 4) * 2048);
            f32x4* dst = (f32x4*)(p->out + (kv ? O_VS : O_KS) + (size_t)ib * 2048 * 2048);
            for (int k = gtid; k < CH4; k += nth) __builtin_nontemporal_store(__builtin_nontemporal_load(src + k), dst + k); }
    }
}

__device__ __forceinline__ void mixer_phase(int i, LAS char* lds) {
    KP p = getp();
    const int tid = ltid(), wid = tid >> 6, lane = tid & 63, fr = lane & 15, fq = lane >> 4;
    unsigned char* ws = p->ws;
    const bf16_t* proj = (const bf16_t*)(ws + WS_PROJ); bf16_t* zcat = (bf16_t*)(ws + WS_ZCAT);
    const bf16_t* plinT = (const bf16_t*)(ws + WS_PLIN) + (size_t)i * 4 * 65536;
    const float* pscale = p->in[I_PSCALE] + i * 1024; const float* convw = p->in[I_CONVW] + i * 3 * 1024;
    constexpr int APITCH = 528;
    constexpr int UROWS = 143, AOFF = 75520;
    for (int task = blockIdx.x; task < 256; task += gridDim.x) {
        const int rt = task >> 2, g = task & 3, b = rt >> 5, t0 = (rt & 31) * 128, kwin = 2 << g;
        const size_t rbase = (size_t)b * 4096;
        const int chunk = tid & 31, rowgrp = tid >> 5;
        {
            const bf16_t* ub = proj + g * 256 + chunk * 8;
#pragma unroll
            for (int j = 0; j < 9; ++j) {
                const int lr = rowgrp + 16 * j;
                if (lr < UROWS) {
                    const int t = t0 - 15 + lr;
                    u32x4 v = {0u, 0u, 0u, 0u};
                    if (t >= 0) v = *(const u32x4*)(ub + (rbase + t) * NABO);
                    *(LAS u32x4*)(lds + lr * APITCH + chunk * 16) = v;
                }
            }
        }
        {
            const int c = g * 256 + chunk * 8;
            f32x4 w0a = *(const f32x4*)(convw + c), w0b = *(const f32x4*)(convw + c + 4), w1a = *(const f32x4*)(convw + 1024 + c), w1b = *(const f32x4*)(convw + 1024 + c + 4),
                  w2a = *(const f32x4*)(convw + 2048 + c), w2b = *(const f32x4*)(convw + 2048 + c + 4);
            const float w0[8] = {w0a[0], w0a[1], w0a[2], w0a[3], w0b[0], w0b[1], w0b[2], w0b[3]};
            const float w1[8] = {w1a[0], w1a[1], w1a[2], w1a[3], w1b[0], w1b[1], w1b[2], w1b[3]};
            const float w2[8] = {w2a[0], w2a[1], w2a[2], w2a[3], w2b[0], w2b[1], w2b[2], w2b[3]};
            float* cpo = p->out + O_CP + ((size_t)(i * 2 + b) * 2) * 1024 + c;
#pragma unroll 4
            for (int j = 0; j < 8; ++j) {
                const int t = t0 + rowgrp + 16 * j; const size_t ro = (rbase + t) * NABO + c;
                const u32x4 z4 = {0u, 0u, 0u, 0u};
                const u32x4 z0 = *(const u32x4*)(proj + ro + 2048);
                const u32x4 z1 = t >= 1 ? *(const u32x4*)(proj + ro - NABO + 2048) : z4;
                const u32x4 z2 = t >= 2 ? *(const u32x4*)(proj + ro - 2 * NABO + 2048) : z4;
                const u32x4 bg = *(const u32x4*)(proj + ro + 3072);
                u32x4 ov;
#pragma unroll
                for (int e = 0; e < 4; ++e) {
                    const float ya = bflo(z2[e]) * w0[2 * e] + bflo(z1[e]) * w1[2 * e] + bflo(z0[e]) * w2[2 * e];
                    const float yb = bfhi(z2[e]) * w0[2 * e + 1] + bfhi(z1[e]) * w1[2 * e + 1] + bfhi(z0[e]) * w2[2 * e + 1];
                    ov[e] = cvt_pk_bf16(bflo(bg[e]) * ya, bfhi(bg[e]) * yb);
                }
                *(u32x4*)(zcat + (rbase + t) * DM + 1024 + c) = ov;
                if (t >= 4094) { float* d = cpo + (size_t)(t - 4094) * 1024; *(f32x4*)d = (f32x4){bflo(z0[0]), bfhi(z0[0]), bflo(z0[1]), bfhi(z0[1])}; *(f32x4*)(d + 4) = (f32x4){bflo(z0[2]), bfhi(z0[2]), bflo(z0[3]), bfhi(z0[3])}; }
            }
        }
        __syncthreads();
        {
            float* pp = p->out + O_PP + ((size_t)(i * 2 + b) * 15) * 1024 + g * 256 + chunk * 8;
#pragma unroll 2
            for (int j = 0; j < 8; ++j) {
                const int lr = rowgrp + 16 * j, t = t0 + lr;
                float sacc[8];
#pragma unroll
                for (int e = 0; e < 8; ++e) sacc[e] = 0.f;
                u32x4 cur = {0u, 0u, 0u, 0u};
                for (int j2 = 0; j2 < kwin; ++j2) {
                    const u32x4 v = *(LAS const u32x4*)(lds + (lr + 15 - j2) * APITCH + chunk * 16);
                    if (j2 == 0) cur = v;
#pragma unroll
                    for (int e = 0; e < 4; ++e) { sacc[2 * e] += bflo(v[e]); sacc[2 * e + 1] += bfhi(v[e]); }
                }
                const float inv = 1.f / fminf((float)kwin, (float)(t + 1));
                u32x4 ov;
#pragma unroll
                for (int e = 0; e < 4; ++e) ov[e] = cvt_pk_bf16(sacc[2 * e] * inv - bflo(cur[e]), sacc[2 * e + 1] * inv - bfhi(cur[e]));
                *(LAS u32x4*)(lds + AOFF + lr * APITCH + chunk * 16) = ov;
                if (t >= 4081) { float* d = pp + (size_t)(t - 4081) * 1024;
                    *(f32x4*)d = (f32x4){bflo(cur[0]), bfhi(cur[0]), bflo(cur[1]), bfhi(cur[1])}; *(f32x4*)(d + 4) = (f32x4){bflo(cur[2]), bfhi(cur[2]), bflo(cur[3]), bfhi(cur[3])}; }
            }
        }
        __syncthreads();
        {
            const int wr = wid >> 2, wc = wid & 3;
            f32x4 acc[4][4];
#pragma unroll
            for (int m = 0; m < 4; ++m)
#pragma unroll
                for (int n = 0; n < 4; ++n) acc[m][n] = (f32x4){0.f, 0.f, 0.f, 0.f};
            const bf16_t* Bg = plinT + (size_t)g * 65536 + (size_t)(wc * 64 + fr) * 256 + fq * 8;
            LAS const char* Al = lds + AOFF + (wr * 64 + fr) * APITCH + fq * 16;
#pragma unroll 2
            for (int ks = 0; ks < 8; ++ks) {
                bf16x8 a[4], bb[4];
#pragma unroll
                for (int m = 0; m < 4; ++m) a[m] = *(LAS const bf16x8*)(Al + m * 16 * APITCH + ks * 64);
#pragma unroll
                for (int n = 0; n < 4; ++n) bb[n] = *(const bf16x8*)(Bg + (size_t)n * 16 * 256 + ks * 32);
#pragma unroll
                for (int m = 0; m < 4; ++m)
#pragma unroll
                    for (int n = 0; n < 4; ++n) acc[m][n] = __builtin_amdgcn_mfma_f32_16x16x32_bf16(bb[n], a[m], acc[m][n], 0, 0, 0);
            }
#pragma unroll
            for (int m = 0; m < 4; ++m) {
                const int lr = wr * 64 + m * 16 + fr;
#pragma unroll
                for (int n = 0; n < 4; ++n) {
                    const int cl = wc * 64 + n * 16 + fq * 4;
                    const f32x4 sc = *(const f32x4*)(pscale + g * 256 + cl);
                    const f32x4 v = acc[m][n] * sc;
                    u32x2 w; w.x = cvt_pk_bf16(v[0], v[1]); w.y = cvt_pk_bf16(v[2], v[3]);
                    *(LAS u32x2*)(lds + lr * APITCH + cl * 2) = w;
                }
            }
        }
        __syncthreads();
        {
#pragma unroll 4
            for (int j = 0; j < 8; ++j) {
                const int lr = rowgrp + 16 * j; const size_t row = rbase + t0 + lr; const int ch = g * 256 + chunk * 8;
                const u32x4 a = *(LAS const u32x4*)(lds + lr * APITCH + chunk * 16);
                const u32x4 sg = *(const u32x4*)(proj + row * NABO + 1024 + ch);
                u32x4 ov;
#pragma unroll
                for (int e = 0; e < 4; ++e) ov[e] = cvt_pk_bf16(bflo(a[e]) * bflo(sg[e]), bfhi(a[e]) * bfhi(sg[e]));
                *(u32x4*)(zcat + row * DM + ch) = ov;
            }
        }
        __syncthreads();
    }
    for (int st = blockIdx.x; st < 256; st += gridDim.x) {
        const int b = st >> 5, g = (st >> 3) & 3, dq = st & 7, kwin = 2 << g;
        LAS float* PS = (LAS float*)lds;
        LAS float* RS = PS + 1024;
        if (tid < 256) {
            const int c = g * 256 + tid;
            float ua[19];
            const float* sp = p->in[I_SPOOL] + ((size_t)(i * 8 + b) * 15) * 1024 + c;
#pragma unroll
            for (int j = 0; j < 15; ++j) ua[j] = sp[(size_t)j * 1024];
#pragma unroll
            for (int s = 0; s < 4; ++s) ua[15 + s] = bf2f(proj[(size_t)(MP + b * 4 + s) * NABO + c]);
            const float inv = 1.f / (float)kwin;
#pragma unroll
            for (int s = 0; s < 4; ++s) {
                float a = 0.f;
#pragma unroll
                for (int j = 0; j < 16; ++j) a += (j < kwin) ? ua[15 + s - j] : 0.f;
                PS[s * 256 + tid] = a * inv - ua[15 + s];
            }
            if (dq == 0) {
                float* po = p->out + O_PS + ((size_t)(i * 8 + b) * 15) * 1024 + c;
#pragma unroll
                for (int j = 0; j < 15; ++j) po[(size_t)j * 1024] = ua[4 + j];
            }
        } else if (dq == 0) {
            const int c = g * 256 + (tid - 256);
            const float* scv = p->in[I_SCONV] + ((size_t)(i * 8 + b) * 2) * 1024 + c;
            float za[6]; za[0] = scv[0]; za[1] = scv[1024];
#pragma unroll
            for (int s = 0; s < 4; ++s) za[2 + s] = bf2f(proj[(size_t)(MP + b * 4 + s) * NABO + 2048 + c]);
            const float w0 = convw[c], w1 = convw[1024 + c], w2 = convw[2048 + c];
#pragma unroll
            for (int s = 0; s < 4; ++s) {
                const size_t ro = (size_t)(MP + b * 4 + s) * NABO;
                const float y = za[s] * w0 + za[s + 1] * w1 + za[s + 2] * w2;
                zcat[(size_t)(MP + b * 4 + s) * DM + 1024 + c] = (bf16_t)(cvt_pk_bf16(bf2f(proj[ro + 3072 + c]) * y, 0.f) & 0xffffu);
            }
            float* co = p->out + O_CS + ((size_t)(i * 8 + b) * 2) * 1024 + c;
            co[0] = za[4]; co[1024] = za[5];
        }
        __syncthreads();
        {
            const int dl = tid & 31, s = (tid >> 5) & 3, cs = tid >> 7;
            const float* P = p->in[I_PLIN] + ((size_t)(i * 4 + g) * 256 + cs * 64) * 256 + dq * 32 + dl;
            LAS const float* ps = PS + s * 256 + cs * 64;
            float a = 0.f;
#pragma unroll 16
            for (int c2 = 0; c2 < 64; ++c2) a += ps[c2] * P[(size_t)c2 * 256];
            RS[(cs * 4 + s) * 32 + dl] = a;
        }
        __syncthreads();
        if (tid < 128) {
            const int dl = tid & 31, s = tid >> 5, ch = g * 256 + dq * 32 + dl;
            const float a = (RS[s * 32 + dl] + RS[(4 + s) * 32 + dl]) + (RS[(8 + s) * 32 + dl] + RS[(12 + s) * 32 + dl]);
            const size_t row = (size_t)(MP + b * 4 + s);
            zcat[row * DM + ch] = (bf16_t)(cvt_pk_bf16(a * pscale[ch] * bf2f(proj[row * NABO + 1024 + ch]), 0.f) & 0xffffu);
        }
        __syncthreads();
    }
}

__device__ __forceinline__ int crow(int r, int hi) { return (r & 3) + 8 * (r >> 2) + 4 * hi; }
__device__ __forceinline__ s16x4 vtr(LAS const char* ptr) { return __builtin_bit_cast(s16x4, __builtin_amdgcn_ds_read_tr16_b64_v4i16((LAS v4i16_t*)ptr)); }
#define VM_WAIT(n) asm volatile("s_waitcnt vmcnt(" #n ")" ::: "memory")
#define TR8(base, off, a0, a1, a2, a3, a4, a5, a6, a7) asm volatile( \
    "ds_read_b64_tr_b16 %0, %8 offset:%9\n\tds_read_b64_tr_b16 %1, %8 offset:%9+512\n\tds_read_b64_tr_b16 %2, %8 offset:%9+1024\n\tds_read_b64_tr_b16 %3, %8 offset:%9+1536\n\t" \
    "ds_read_b64_tr_b16 %4, %8 offset:%9+2048\n\tds_read_b64_tr_b16 %5, %8 offset:%9+2560\n\tds_read_b64_tr_b16 %6, %8 offset:%9+3072\n\tds_read_b64_tr_b16 %7, %8 offset:%9+3584\n\t" \
    "s_waitcnt lgkmcnt(0)" \
    : "=&v"(a0), "=&v"(a1), "=&v"(a2), "=&v"(a3), "=&v"(a4), "=&v"(a5), "=&v"(a6), "=&v"(a7) : "v"(base), "i"(off) : "memory")
__device__ __forceinline__ void attn_issue_k(bf16x8 (&kf)[8], const bf16_t* kb, size_t rowb, int mk0, int dil, int lane) {
    const int r32 = lane & 31, hi = lane >> 5;
    const bf16_t* kp = kb + (rowb + (size_t)(mk0 + r32) * dil) * 128 + hi * 8;
#pragma unroll
    for (int d0 = 0; d0 < 8; ++d0) kf[d0] = *(const bf16x8*)(kp + d0 * 16);
}
__device__ __forceinline__ void attn_issue_v(const bf16_t* vb, size_t rowb, int mk0, int dil, LAS char* vbuf, int lane) {
    const bf16_t* vp0 = vb + (rowb + (size_t)(mk0 + (lane >> 2)) * dil) * 128 + (lane & 3) * 8;
    const bf16_t* vp1 = vp0 + (size_t)16 * dil * 128;
#pragma unroll
    for (int ii = 0; ii < 8; ++ii)
        __builtin_amdgcn_global_load_lds((const unsigned*)(((ii & 1) ? vp1 : vp0) + (ii >> 1) * 32), (LAS unsigned*)(vbuf + ii * 1024), 16, 0, 0);
}
__device__ __forceinline__ void attn_wave_task(const bf16_t* qkvg, int b, int h, int dil, int r, int m0, bf16_t* og, float* lse, LAS char* vl, int lane) {
    const int r32 = lane & 31, hi = lane >> 5;
    const size_t hb = (size_t)(b * 16 + h) * 4096 * 128;
    const bf16_t* qb = qkvg + hb, * kb = qkvg + HM + hb, * vb = qkvg + 2 * HM + hb;
    const size_t rowb = (size_t)r;
    const size_t qrow = rowb + (size_t)(m0 + r32) * dil;
    int kt = m0 >= 128 ? 0 : (128 - m0) / 32;
    int par = 0;
    bf16x8 kf[8];
    attn_issue_v(vb, rowb, m0 - 128 + 32 * kt, dil, vl, lane);
    attn_issue_k(kf, kb, rowb, m0 - 128 + 32 * kt, dil, lane);
    bf16x8 qf[8];
#pragma unroll
    for (int d0 = 0; d0 < 8; ++d0) qf[d0] = *(const bf16x8*)(qb + qrow * 128 + d0 * 16 + hi * 8);
    f32x16 o[4];
#pragma unroll
    for (int dt = 0; dt < 4; ++dt)
#pragma unroll
        for (int e = 0; e < 16; ++e) o[dt][e] = 0.f;
    float m_run = -1e30f, l_run = 0.f;
    const int i16 = lane & 15, tq = i16 >> 2, tp = i16 & 3, dblk = (lane >> 4) & 1;
    const unsigned tr0 = (unsigned)(size_t)vl + (4 * hi + tq) * 64 + dblk * 32 + 8 * tp;
    for (;;) {
        const bool hn = kt + 1 < 5;
        f32x16 pt;
#pragma unroll
        for (int e = 0; e < 16; ++e) pt[e] = 0.f;
#pragma unroll
        for (int d0 = 0; d0 < 8; ++d0) pt = __builtin_amdgcn_mfma_f32_32x32x16_bf16(kf[d0], qf[d0], pt, 0, 0, 0);
        asm volatile("" : "+v"(pt) :: "memory");
        if (hn) {
            attn_issue_v(vb, rowb, m0 - 128 + 32 * (kt + 1), dil, vl + (par ^ 1) * 8192, lane);
            attn_issue_k(kf, kb, rowb, m0 - 128 + 32 * (kt + 1), dil, lane);
        }
        asm volatile("" ::: "memory");
        const float NEG = -__builtin_inff();
        if (kt == 0) {
#pragma unroll
            for (int e = 0; e < 16; ++e) if (crow(e, hi) < r32) pt[e] = NEG;
        }
        if (kt == 4) {
#pragma unroll
            for (int e = 0; e < 16; ++e) if (crow(e, hi) > r32) pt[e] = NEG;
        }
        float tmax = pt[0];
#pragma unroll
        for (int e = 1; e < 16; ++e) tmax = fmaxf(tmax, pt[e]);
        { auto rr = __builtin_amdgcn_permlane32_swap(__float_as_uint(tmax), __float_as_uint(tmax), false, false); tmax = fmaxf(__uint_as_float(rr[0]), __uint_as_float(rr[1])); }
        const float mn = fmaxf(m_run, tmax), alpha = __builtin_amdgcn_exp2f(m_run - mn); m_run = mn;
        float ps = 0.f;
#pragma unroll
        for (int e = 0; e < 16; ++e) { pt[e] = __builtin_amdgcn_exp2f(pt[e] - mn); ps += pt[e]; }
        { auto rr = __builtin_amdgcn_permlane32_swap(__float_as_uint(ps), __float_as_uint(ps), false, false); ps = __uint_as_float(rr[0]) + __uint_as_float(rr[1]); }
        l_run = l_run * alpha + ps;
        if (__any(alpha != 1.f)) {
#pragma unroll
            for (int dt = 0; dt < 4; ++dt)
#pragma unroll
                for (int e = 0; e < 16; ++e) o[dt][e] *= alpha;
        }
        bf16x8 pb[2];
#pragma unroll
        for (int s = 0; s < 2; ++s) {
            u32x4 w; w.x = cvt_pk_bf16(pt[8 * s + 0], pt[8 * s + 1]); w.y = cvt_pk_bf16(pt[8 * s + 2], pt[8 * s + 3]); w.z = cvt_pk_bf16(pt[8 * s + 4], pt[8 * s + 5]); w.w = cvt_pk_bf16(pt[8 * s + 6], pt[8 * s + 7]);
            pb[s] = __builtin_bit_cast(bf16x8, w);
        }
        if (hn) VM_WAIT(16); else VM_WAIT(0);
        const unsigned trb = tr0 + par * 8192;
#pragma unroll
        for (int dp = 0; dp < 2; ++dp) {
            s16x4 a0, a1, a2, a3, a4, a5, a6, a7;
            if (dp == 0) TR8(trb, 0, a0, a1, a2, a3, a4, a5, a6, a7); else TR8(trb, 4096, a0, a1, a2, a3, a4, a5, a6, a7);
            o[2 * dp] = __builtin_amdgcn_mfma_f32_32x32x16_bf16(__builtin_shufflevector(a0, a1, 0, 1, 2, 3, 4, 5, 6, 7), pb[0], o[2 * dp], 0, 0, 0);
            o[2 * dp] = __builtin_amdgcn_mfma_f32_32x32x16_bf16(__builtin_shufflevector(a2, a3, 0, 1, 2, 3, 4, 5, 6, 7), pb[1], o[2 * dp], 0, 0, 0);
            o[2 * dp + 1] = __builtin_amdgcn_mfma_f32_32x32x16_bf16(__builtin_shufflevector(a4, a5, 0, 1, 2, 3, 4, 5, 6, 7), pb[0], o[2 * dp + 1], 0, 0, 0);
            o[2 * dp + 1] = __builtin_amdgcn_mfma_f32_32x32x16_bf16(__builtin_shufflevector(a6, a7, 0, 1, 2, 3, 4, 5, 6, 7), pb[1], o[2 * dp + 1], 0, 0, 0);
        }
        if (!hn) break;
        ++kt; par ^= 1;
    }
    const float inv = 1.f / l_run;
    asm volatile("s_waitcnt vmcnt(0)" ::: "memory");
#pragma unroll
    for (int dt = 0; dt < 4; ++dt)
#pragma unroll
        for (int g4 = 0; g4 < 4; ++g4) {
            u32x2 w; w.x = cvt_pk_bf16(o[dt][4 * g4] * inv, o[dt][4 * g4 + 1] * inv); w.y = cvt_pk_bf16(o[dt][4 * g4 + 2] * inv, o[dt][4 * g4 + 3] * inv);
            *(LAS u32x2*)(vl + r32 * 272 + (dt * 32 + 8 * g4 + 4 * hi) * 2) = w;
        }
    __builtin_amdgcn_fence(__ATOMIC_RELEASE, "wavefront"); __builtin_amdgcn_wave_barrier();
#pragma unroll
    for (int k = 0; k < 8; ++k) {
        const int c = k * 64 + lane, rw = c >> 4, c16 = c & 15;
        const u32x4 w = *(LAS const u32x4*)(vl + rw * 272 + c16 * 16);
        *(u32x4*)(og + hb + (rowb + (size_t)(m0 + rw) * dil) * 128 + c16 * 8) = w;
    }
    __builtin_amdgcn_wave_barrier();
    if (hi == 0) lse[((size_t)(b * 16 + h) * 4096) + qrow] = m_run + __builtin_amdgcn_logf(l_run);
}
__device__ __forceinline__ void attn_sample_wave(KP p, int i, int b, int s, int h, int g, LAS float* part, int lane) {
    const bf16_t* qs = (const bf16_t*)(p->ws + WS_QS);
    const int kq = lane >> 4, dc = lane & 15, dil = 1 << (2 * g);
    LAS float* sc = part + 136;
    float q8[8];
    { const bf16x8 qv = *(const bf16x8*)(qs + (size_t)(b * 4 + s) * DM + h * 128 + dc * 8);
#pragma unroll
      for (int e = 0; e < 8; ++e) q8[e] = bf2f((bf16_t)qv[e]); }
    const size_t cbase = ((size_t)(i * 8 + b) * 2048) * 2048 + h * 128 + dc * 8;
    const float* ck = p->in[I_CK] + cbase; const float* cv = p->in[I_CV] + cbase;
    const float* kn = p->out + O_KS + cbase + (size_t)2044 * 2048;
    const float* vn = p->out + O_VS + cbase + (size_t)2044 * 2048;
#pragma unroll 1
    for (int bt = 0; bt < 3; ++bt) {
        f32x4 ka[11], kb2[11];
#pragma unroll
        for (int u = 0; u < 11; ++u) {
            const int j = (bt * 11 + u) * 4 + kq, jc = j > 128 ? 128 : j, idx = 2048 + s - dil * jc;
            const float* kr = idx >= 2048 ? kn + (size_t)(idx - 2048) * 2048 : ck + (size_t)idx * 2048;
            ka[u] = *(const f32x4*)kr; kb2[u] = *(const f32x4*)(kr + 4);
        }
#pragma unroll
        for (int u = 0; u < 11; ++u) {
            const int j = (bt * 11 + u) * 4 + kq;
            float d = (ka[u][0] * q8[0] + ka[u][1] * q8[1]) + (ka[u][2] * q8[2] + ka[u][3] * q8[3]) + (kb2[u][0] * q8[4] + kb2[u][1] * q8[5]) + (kb2[u][2] * q8[6] + kb2[u][3] * q8[7]);
            d += __shfl_xor(d, 1); d += __shfl_xor(d, 2); d += __shfl_xor(d, 4); d += __shfl_xor(d, 8);
            if (dc == 0) sc[j] = j <= 128 ? d : -1e30f;
        }
    }
    __builtin_amdgcn_fence(__ATOMIC_RELEASE, "wavefront"); __builtin_amdgcn_wave_barrier();
    float s0 = sc[lane], s1 = sc[lane + 64], s2 = lane < 4 ? sc[lane + 128] : -1e30f;
    const float mx = wave_max(fmaxf(s0, fmaxf(s1, s2)));
    s0 = __builtin_amdgcn_exp2f(s0 - mx); s1 = __builtin_amdgcn_exp2f(s1 - mx); s2 = __builtin_amdgcn_exp2f(s2 - mx);
    const float sum = wave_sum(s0 + s1 + s2);
    sc[lane] = s0; sc[lane + 64] = s1; if (lane < 4) sc[lane + 128] = s2;
    __builtin_amdgcn_fence(__ATOMIC_RELEASE, "wavefront"); __builtin_amdgcn_wave_barrier();
    float o8[8];
#pragma unroll
    for (int e = 0; e < 8; ++e) o8[e] = 0.f;
#pragma unroll 1
    for (int bt = 0; bt < 3; ++bt) {
        f32x4 va[11], vb2[11];
#pragma unroll
        for (int u = 0; u < 11; ++u) {
            const int j = (bt * 11 + u) * 4 + kq, jc = j > 128 ? 128 : j, idx = 2048 + s - dil * jc;
            const float* vr = idx >= 2048 ? vn + (size_t)(idx - 2048) * 2048 : cv + (size_t)idx * 2048;
            va[u] = *(const f32x4*)vr; vb2[u] = *(const f32x4*)(vr + 4);
        }
#pragma unroll
        for (int u = 0; u < 11; ++u) {
            const float pj = sc[(bt * 11 + u) * 4 + kq];
#pragma unroll
            for (int e = 0; e < 4; ++e) { o8[e] += pj * va[u][e]; o8[4 + e] += pj * vb2[u][e]; }
        }
    }
#pragma unroll
    for (int e = 0; e < 8; ++e) { o8[e] += __shfl_xor(o8[e], 16); o8[e] += __shfl_xor(o8[e], 32); }
    if (kq == 0) {
#pragma unroll
        for (int e = 0; e < 8; ++e) part[2 + dc * 8 + e] = o8[e];
    }
    if (lane == 0) { part[0] = mx; part[1] = sum; }
}
__device__ __forceinline__ void attn_phase(int i, LAS char* lds) {
    KP p = getp();
    const int tid = ltid(), wid = __builtin_amdgcn_readfirstlane(tid >> 6), lane = tid & 63;
    const bf16_t* qkvg = (const bf16_t*)(p->ws + WS_PROJ); bf16_t* zcat = (bf16_t*)(p->ws + WS_ZCAT); const bf16_t* sgb = (const bf16_t*)(p->ws + WS_SG);
    bf16_t* og = (bf16_t*)(p->ws + WS_OG); float* lse = (float*)(p->ws + WS_LSE);
    for (int base = blockIdx.x * 2; base < 512; base += gridDim.x * 2) {
        LAS float* parts = (LAS float*)lds;
#ifndef NO_SAMPLE
        if (wid < 6) { const int id = base + wid / 3; attn_sample_wave(p, i, id >> 6, (id >> 4) & 3, id & 15, wid % 3, parts + wid * 272, lane); }
#endif
        __syncthreads();
        if (tid < 256) {
            const int pr = tid >> 7, d = tid & 127, id = base + pr, row = MP + (id >> 6) * 4 + ((id >> 4) & 3), h = id & 15;
            LAS const float* P0 = parts + (pr * 3) * 272, * P1 = P0 + 272, * P2 = P1 + 272;
            const float mx = fmaxf(P0[0], fmaxf(P1[0], P2[0]));
            const float w0 = __builtin_amdgcn_exp2f(P0[0] - mx), w1 = __builtin_amdgcn_exp2f(P1[0] - mx), w2 = __builtin_amdgcn_exp2f(P2[0] - mx);
            const float L = w0 * P0[1] + w1 * P1[1] + w2 * P2[1];
            const float o = (w0 * P0[2 + d] + w1 * P1[2 + d] + w2 * P2[2 + d]) / L;
            const float sg = bf2f(sgb[(size_t)row * DM + h * 128 + d]);
            zcat[(size_t)row * DM + h * 128 + d] = (bf16_t)(cvt_pk_bf16(o * sg, 0.f) & 0xffffu);
        }
        __syncthreads();
    }
    LAS char* wl = lds + wid * 16384;
    {
        const int G = gridDim.x; int xcd, lw, nlw, per;
        if ((G & 7) == 0) { xcd = blockIdx.x & 7; lw = (blockIdx.x >> 3) * 8 + wid; nlw = G; per = 1536; }
        else { xcd = 0; lw = blockIdx.x * 8 + wid; nlw = G * 8; per = 12288; }
#ifdef PROBE_WT2
        for (int rep = 0; rep < 2; ++rep)
#endif
        for (int tau = lw; tau < per; tau += nlw) {
            const int bhi = tau / 384, within = tau - bhi * 384, win = within / 48, tk = within - win * 48;
            const int bh = (per == 1536) ? xcd + 8 * bhi : bhi, b = bh >> 4, h = bh & 15, T0 = win * 512;
            const int g = tk >> 4, sub = tk & 15;
            int dil, r, m0;
            if (g == 0) { dil = 1; r = 0; m0 = T0 + 32 * sub; }
            else if (g == 1) { dil = 4; r = sub & 3; m0 = (T0 >> 2) + 32 * (sub >> 2); }
            else { dil = 16; r = sub; m0 = T0 >> 4; }
#ifndef NO_MAIN
            attn_wave_task(qkvg, b, h, dil, r, m0, og + (size_t)g * HM, lse + (size_t)g * MP * 16, wl, lane);
#endif
        }
    }
}
__device__ __forceinline__ void attn_merge_phase() {
    KP p = getp();
    const int tid = ltid();
    bf16_t* zcat = (bf16_t*)(p->ws + WS_ZCAT); const bf16_t* sgb = (const bf16_t*)(p->ws + WS_SG);
    const bf16_t* og = (const bf16_t*)(p->ws + WS_OG); const float* lse = (const float*)(p->ws + WS_LSE);
    const int nth = gridDim.x * 512;
#pragma unroll 2
    for (int idx = blockIdx.x * 512 + tid; idx < MP * 256; idx += nth) {
        const int row = idx >> 8, chunk = idx & 255, h = chunk >> 4, b = row >> 12, t = row & 4095;
        const size_t li = (size_t)(b * 16 + h) * 4096 + t, oi = li * 128 + (chunk & 15) * 8;
        const float l0 = lse[li], l1 = lse[(size_t)MP * 16 + li], l2 = lse[(size_t)2 * MP * 16 + li];
        const float mx = fmaxf(l0, fmaxf(l1, l2));
        float w0 = __builtin_amdgcn_exp2f(l0 - mx), w1 = __builtin_amdgcn_exp2f(l1 - mx), w2 = __builtin_amdgcn_exp2f(l2 - mx);
        const float inv = 1.f / (w0 + w1 + w2); w0 *= inv; w1 *= inv; w2 *= inv;
        const u32x4 a0 = *(const u32x4*)(og + oi), a1 = *(const u32x4*)(og + HM + oi), a2 = *(const u32x4*)(og + 2 * HM + oi);
        const u32x4 sg = *(const u32x4*)(sgb + (size_t)row * DM + chunk * 8);
        u32x4 ov;
#pragma unroll
        for (int e = 0; e < 4; ++e) {
            const float lo = (w0 * bflo(a0[e]) + w1 * bflo(a1[e]) + w2 * bflo(a2[e])) * bflo(sg[e]);
            const float hi = (w0 * bfhi(a0[e]) + w1 * bfhi(a1[e]) + w2 * bfhi(a2[e])) * bfhi(sg[e]);
            ov[e] = cvt_pk_bf16(lo, hi);
        }
        *(u32x4*)(zcat + (size_t)row * DM + chunk * 8) = ov;
    }
}

template <int KIND> __device__ __forceinline__ void gemm_stage(int i, PG8_LAS unsigned char* lds) {
    KP p = getp(); unsigned char* ws = p->ws;
    int G = gridDim.x, c = blockIdx.x; asm volatile("" : "+s"(G), "+s"(c));
    bf16_t* xb = (bf16_t*)(ws + WS_XB); float* hbuf = (float*)(ws + WS_H); float* rss = (float*)(ws + WS_RSS);
    bf16_t* proj = (bf16_t*)(ws + WS_PROJ); bf16_t* zcat = (bf16_t*)(ws + WS_ZCAT);
    const f32x4* csrc = nullptr; f32x4* cdst = nullptr;
    if (G == 256) { const int chunk = c >> 3, part = c & 7, kv = chunk >> 4, ib = chunk & 15;
        csrc = (const f32x4*)(p->in[kv ? I_CV : I_CK] + ((size_t)ib * 2048 + 4) * 2048) + (size_t)part * CP_PER_WG;
        cdst = (f32x4*)(p->out + (kv ? O_VS : O_KS) + (size_t)ib * 2048 * 2048) + (size_t)part * CP_PER_WG; }
    const int seq0 = i * 9 + (KIND == 0 ? 0 : KIND == 1 ? 3 : KIND == 2 ? 4 : 8);
#ifdef STAGGER_TICKS
    if ((KIND == 0 || KIND == 2) && (c & 1)) {
        const unsigned long long t0 = __builtin_amdgcn_s_memrealtime();
        while (__builtin_amdgcn_s_memrealtime() - t0 < STAGGER_TICKS) __builtin_amdgcn_s_sleep(8);
    }
#endif
    if constexpr (KIND == 0) {
        const bf16_t* Wt = (const bf16_t*)(ws + WS_WINAB) + (size_t)i * NAB * DM;
        pg8::Gemm g{xb, Wt, MP, NAB, DM}; pg8::StaticOrder S; S.init(MP, NAB, G, c);
        EpiMain<QInAB> E{{rss + (2 * i) * MT, proj, nullptr}, csrc, cdst, seq0};
        pg8::gemm_phase<EpiMain<QInAB>, pg8::StaticOrder, false>(lds, g, S, E, nullptr);
        skinny_gemm<QInAB>(xb, Wt, NAB, E.q, (LAS char*)lds);
    } else if constexpr (KIND == 1) {
        const bf16_t* Wt = (const bf16_t*)(ws + WS_WOUTAB) + (size_t)i * DM * DM;
        pg8::Gemm g{zcat, Wt, MP, DM, DM}; pg8::StaticOrder S; S.init(MP, DM, G, c);
        if (i == 0) { typedef QOut<0, 0, 1> QT; EpiMain<QT> E{{p->in[I_XP], p->in[I_XS], hbuf, xb, rss + (2 * i + 1) * MT}, csrc, cdst, seq0};
            pg8::gemm_phase<EpiMain<QT>, pg8::StaticOrder, false>(lds, g, S, E, nullptr); skinny_gemm<QT>(zcat, Wt, DM, E.q, (LAS char*)lds); }
        else { typedef QOut<1, 0, 1> QT; EpiMain<QT> E{{nullptr, nullptr, hbuf, xb, rss + (2 * i + 1) * MT}, csrc, cdst, seq0};
            pg8::gemm_phase<EpiMain<QT>, pg8::StaticOrder, false>(lds, g, S, E, nullptr); skinny_gemm<QT>(zcat, Wt, DM, E.q, (LAS char*)lds); }
    } else if constexpr (KIND == 2) {
        const bf16_t* Wt = (const bf16_t*)(ws + WS_WINC) + (size_t)i * NC * DM;
        pg8::Gemm g{xb, Wt, MP, NC, DM}; pg8::StaticOrder S; S.init(MP, NC, G, c);
        float* out = p->out;
        EpiMain<QInC> E{{rss + (2 * i + 1) * MT, proj, (bf16_t*)(ws + WS_QS), out + O_KP + (size_t)i * 2 * 2048 * 2048, out + O_KS + (size_t)i * 8 * 2048 * 2048,
                         out + O_VP + (size_t)i * 2 * 2048 * 2048, out + O_VS + (size_t)i * 8 * 2048 * 2048, nullptr}, csrc, cdst, seq0};
        pg8::gemm_phase<EpiMain<QInC>, pg8::StaticOrder, false>(lds, g, S, E, nullptr);
        skinny_gemm<QInC>(xb, Wt, NC, E.q, (LAS char*)lds);
    } else {
        const bf16_t* Wt = (const bf16_t*)(ws + WS_WOUTC) + (size_t)i * DM * DM;
        pg8::Gemm g{zcat, Wt, MP, DM, DM}; pg8::StaticOrder S; S.init(MP, DM, G, c);
        if (i == 0) { typedef QOut<1, 0, 1> QT; EpiMain<QT> E{{nullptr, nullptr, hbuf, xb, rss + (2 * i + 2) * MT}, csrc, cdst, seq0};
            pg8::gemm_phase<EpiMain<QT>, pg8::StaticOrder, false>(lds, g, S, E, nullptr); skinny_gemm<QT>(zcat, Wt, DM, E.q, (LAS char*)lds); }
        else { typedef QOut<1, 1, 0> QT; EpiMain<QT> E{{nullptr, nullptr, hbuf, xb, rss + (2 * i + 2) * MT}, csrc, cdst, seq0};
            pg8::gemm_phase<EpiMain<QT>, pg8::StaticOrder, false>(lds, g, S, E, nullptr); skinny_gemm<QT>(zcat, Wt, DM, E.q, (LAS char*)lds); }
    }
}
__device__ __forceinline__ void final_phase() {
    KP p = getp();
    const float* hbuf = (const float*)(p->ws + WS_H); const float* rss = (const float*)(p->ws + WS_RSS); float* out = p->out;
    const int tid = ltid(), wid = tid >> 6, lane = tid & 63;
    const float* fw = p->in[I_FNW];
    for (int row = blockIdx.x * 8 + wid; row < MT; row += gridDim.x * 8) {
        const float rs = rsqrtf(rss[4 * MT + row] * (1.f / 2048.f) + 1e-6f);
#pragma unroll
        for (int k = 0; k < 8; ++k) {
            const int col = (k * 64 + lane) * 4;
            const f32x4 v = *(const f32x4*)(hbuf + (size_t)row * DM + col), w = *(const f32x4*)(fw + col);
            __builtin_nontemporal_store(v * rs * w, (f32x4*)(out + (size_t)row * DM + col));
        }
    }
}
__device__ __forceinline__ void gsync_xcd(LAS char* lds) {
    KP p = getp();
    XcdBarrier b; b.bar = (unsigned*)(p->ws + WS_BAR); b.x = xb_xcc_id(); b.st = (volatile LAS unsigned*)(lds + ST_OFF);
    xcd_barrier(b);
}
#define GSYNC() gsync_xcd(lds)
__global__ void __launch_bounds__(512) hybrid_fwd(Params pdummy) {
    extern __shared__ __attribute__((aligned(16))) unsigned char lds_raw[];
    LAS char* lds = (LAS char*)lds_raw;
    PG8_LAS unsigned char* glds = (PG8_LAS unsigned char*)lds_raw;
    cg::grid_group grid = cg::this_grid();
    {
        if (threadIdx.x == 0) { ((volatile LAS unsigned*)(lds + ST_OFF))[0] = 0u; ((volatile LAS unsigned*)(lds + ST_OFF))[1] = 0u; }
        __syncthreads();
        KP p0 = getp();
        (void)xcd_barrier_post((unsigned*)(p0->ws + WS_BAR), (volatile LAS unsigned*)(lds + ST_OFF));
    }
#ifndef SKIP_P0
    phase0(lds);
#ifdef PROBE_P02
    GSYNC(); phase0(lds);
#endif
#endif
    grid.sync();
    for (int i = 0; i < 2; ++i) {
#ifndef SKIP_G1
        gemm_stage<0>(i, glds);
#ifdef PROBE_G2X
        GSYNC(); gemm_stage<0>(i, glds);
#endif
#endif
        GSYNC();
#ifndef SKIP_MIX
        mixer_phase(i, lds);
#ifdef PROBE_MIX2
        GSYNC(); mixer_phase(i, lds);
#endif
#endif
        GSYNC();
#ifndef SKIP_G2
        gemm_stage<1>(i, glds);
#endif
        GSYNC();
#ifndef SKIP_G3
        gemm_stage<2>(i, glds);
#ifdef PROBE_G2X
        GSYNC(); gemm_stage<2>(i, glds);
#endif
#endif
        GSYNC();
#ifndef SKIP_ATT
        attn_phase(i, lds);
        GSYNC();
        attn_merge_phase();
#endif
        GSYNC();
#ifndef SKIP_G4
        gemm_stage<3>(i, glds);
#endif
        GSYNC();
    }
    final_phase();
}

extern "C" void kernel_launch(void* const* d_in, const int* in_sizes, int n_in, void* d_out, int out_size, void* d_ws, size_t ws_size, hipStream_t stream) {
    static int grid = 0;
    if (grid == 0) {
        if (n_in != 15 || (size_t)out_size != O_END || ws_size < WS_END) { fprintf(stderr, "kernel_launch: unexpected shapes (n_in %d out %d ws %zu, need %zu / %zu)\n", n_in, out_size, ws_size, (size_t)O_END, (size_t)WS_END); grid = -1; return; }
        int dev = 0, cus = 0, per_cu = 0;
        hipGetDevice(&dev); hipDeviceGetAttribute(&cus, hipDeviceAttributeMultiprocessorCount, dev);
        if (hipFuncSetAttribute((const void*)hybrid_fwd, hipFuncAttributeMaxDynamicSharedMemorySize, LDS_BYTES) != hipSuccess) { fprintf(stderr, "kernel_launch: hipFuncSetAttribute failed\n"); grid = -1; return; }
        if (hipOccupancyMaxActiveBlocksPerMultiprocessor(&per_cu, (const void*)hybrid_fwd, 512, LDS_BYTES) != hipSuccess || per_cu < 1) { fprintf(stderr, "kernel_launch: occupancy query says %d blocks per CU\n", per_cu); (void)hipGetLastError(); grid = -1; return; }
        grid = cus;
    }
    if (grid < 0) return;
    Params prm{};
    for (int i = 0; i < 15; ++i) prm.in[i] = (const float*)d_in[i];
    prm.out = (float*)d_out; prm.ws = (unsigned char*)d_ws;
    if (hipMemsetAsync((char*)d_ws + WS_BAR, 0, (size_t)XCD_BAR_WORDS * 4, stream) != hipSuccess) { fprintf(stderr, "kernel_launch: memset of the barrier words failed\n"); return; }
    void* args[] = {&prm};
    hipError_t e = hipLaunchCooperativeKernel((const void*)hybrid_fwd, dim3(grid), dim3(512), args, LDS_BYTES, stream);
    if (e != hipSuccess) fprintf(stderr, "cooperative launch failed: %s (grid %d)\n", hipGetErrorString(e), grid);
}
```
